# Optimizing an MI355X kernel written in HIP

```python
import jax, jax.numpy as jnp
from jax import lax
import numpy as np

D_MODEL = 4096
BATCH = 2
SEQ = 4096
DEPTH = 2

CTX_LEN = 256
GRID_W = 64
HEAD_DIM = 128
N_Q_HEADS = 16
N_KV_HEADS = 4
GQA_GROUP = N_Q_HEADS // N_KV_HEADS
ATTN_W = N_Q_HEADS * HEAD_DIM
KV_W = N_KV_HEADS * HEAD_DIM
AXIS_DIM = HEAD_DIM // 2
ROPE_THETA = 10000.0
Q_BLOCK = 128
CONV_W = 1024
CONV_K = 3
GM_W = 1024
GM_GROUPS = 8
GM_GROUP_W = GM_W // GM_GROUPS
GM_CHUNK = 128
N_BRANCH = 3
EPS = 1e-6
ALPHA = (2.0 * DEPTH) ** 0.25
BETA = (8.0 * DEPTH) ** -0.25

IN_SPLITS = (ATTN_W, KV_W, KV_W, ATTN_W,
             CONV_W, CONV_W, CONV_W, CONV_W,
             GM_W, GM_W, GM_W,
             N_BRANCH * D_MODEL)
IN_COLS = sum(IN_SPLITS)
IN_SPLIT_IDX = tuple(int(i) for i in np.cumsum(IN_SPLITS)[:-1])
KV_START = ATTN_W
KV_END = ATTN_W + 2 * KV_W

kernel_name = "hybrid_parallel_gqa_shortconv_gmlp_dit"


def layer_norm(x, g, b):
    xf = x.astype(jnp.float32)
    mu = jnp.mean(xf, axis=-1, keepdims=True)
    var = jnp.mean(jnp.square(xf - mu), axis=-1, keepdims=True)
    return ((xf - mu) * lax.rsqrt(var + EPS) * g + b).astype(x.dtype)


def rms_norm(x, g):
    xf = x.astype(jnp.float32)
    return (xf * lax.rsqrt(jnp.mean(jnp.square(xf), axis=-1, keepdims=True) + EPS) * g).astype(x.dtype)


def rope_2d_tables(rows):
    t = jnp.arange(rows * GRID_W)
    pos = jnp.stack([(t // GRID_W), (t % GRID_W)], axis=-1).astype(jnp.float32)
    freqs = ROPE_THETA ** (-jnp.arange(0, AXIS_DIM, 2, dtype=jnp.float32) / AXIS_DIM)
    ang = pos[:, :, None] * freqs
    return jnp.cos(ang), jnp.sin(ang)


def apply_rope_2d(x, cos, sin):
    b, n, h, _ = x.shape
    xa = x.reshape(b, n, h, 2, AXIS_DIM).astype(jnp.float32)
    half = AXIS_DIM // 2
    x1, x2 = xa[..., :half], xa[..., half:]
    cs, sn = cos[None, :, None], sin[None, :, None]
    out = jnp.concatenate([x1 * cs - x2 * sn, x2 * cs + x1 * sn], axis=-1)
    return out.reshape(b, n, h, HEAD_DIM).astype(x.dtype)


def modulation(cond, w_ada, b_ada):
    return jnp.split(jax.nn.silu(cond) @ w_ada + b_ada, 3, axis=-1)


def q_heads(q, q_norm, rope):
    b, n, _ = q.shape
    q = rms_norm(q.reshape(b, n, N_Q_HEADS, HEAD_DIM), q_norm)
    return q if rope is None else apply_rope_2d(q, *rope)


def kv_heads(k, v, k_norm, rope):
    b, n, _ = k.shape
    k = rms_norm(k.reshape(b, n, N_KV_HEADS, HEAD_DIM), k_norm)
    v = v.reshape(b, n, N_KV_HEADS, HEAD_DIM)
    return (k if rope is None else apply_rope_2d(k, *rope)), v


def gqa_attention(q, k, v):
    b, n, _, _ = q.shape
    nb = n // Q_BLOCK
    scale = HEAD_DIM ** -0.5
    qb = q.reshape(b, nb, Q_BLOCK, N_KV_HEADS, GQA_GROUP, HEAD_DIM).transpose(1, 0, 2, 3, 4, 5)

    def block(qblk):
        s = jnp.einsum('bqkgd,bskd->bkgqs', qblk, k, preferred_element_type=jnp.float32) * scale
        p = jax.nn.softmax(s, axis=-1).astype(v.dtype)
        return jnp.einsum('bkgqs,bskd->bqkgd', p, v)

    o = lax.map(block, qb)
    return o.transpose(1, 0, 2, 3, 4, 5).reshape(b, n, ATTN_W)


def short_gated_conv(b_gate, c_gate, h, conv_w):
    z = c_gate * h
    n = z.shape[1]
    zp = jnp.pad(z, ((0, 0), (1, 1), (0, 0)))
    y = conv_w[0] * zp[:, :n] + conv_w[1] * zp[:, 1:n + 1] + conv_w[2] * zp[:, 2:]
    return b_gate * y


def spatial_gating(u, v, ln_g, ln_b, ws, bias):
    b, n, _ = v.shape
    vn = layer_norm(v, ln_g, ln_b).reshape(b, n // GM_CHUNK, GM_CHUNK, GM_GROUPS, GM_GROUP_W)
    s = jnp.einsum('gpq,bcqgd->bcpgd', ws, vn) + bias.T[None, None, :, :, None]
    return u * s.reshape(b, n, GM_W)


def mixer_sublayer(parts, q, k, v, conv_w, gm_ln_g, gm_ln_b, gm_ws, gm_b,
                   w_br_attn, w_br_conv, w_br_gm, w_out):
    _, _, _, a_gate, c_b, c_c, c_h, c_gate, g_u, g_v, g_gate, m_gate = parts
    y_attn = gqa_attention(q, k, v) * jax.nn.silu(a_gate)
    y_conv = short_gated_conv(c_b, c_c, c_h, conv_w) * jax.nn.silu(c_gate)
    y_gm = spatial_gating(g_u, g_v, gm_ln_g, gm_ln_b, gm_ws, gm_b) * jax.nn.silu(g_gate)
    g_attn, g_conv, g_gm = jnp.split(jax.nn.sigmoid(m_gate), N_BRANCH, axis=-1)
    merged = (g_attn * (y_attn @ w_br_attn) + g_conv * (y_conv @ w_br_conv)
              + g_gm * (y_gm @ w_br_gm))
    return merged @ w_out


def setup_inputs(seed: int = 0) -> dict:
    key = jax.random.key(seed)
    ks = jax.random.split(key, 24)
    f32 = jnp.float32
    nrm = lambda k, shape, s: jax.random.normal(k, shape, f32) * s
    return {
        "x": nrm(ks[0], (BATCH, SEQ, D_MODEL), 1.0),
        "c": nrm(ks[1], (BATCH, D_MODEL), 1.0),
        "ctx": nrm(ks[2], (BATCH, CTX_LEN, D_MODEL), 1.0),
        "c_ctx": nrm(ks[3], (D_MODEL,), 1.0),
        "w_ada": nrm(ks[4], (DEPTH, D_MODEL, 3 * D_MODEL), D_MODEL ** -0.5),
        "b_ada": nrm(ks[5], (DEPTH, 3 * D_MODEL), 0.01),
        "w_in": nrm(ks[6], (DEPTH, D_MODEL, IN_COLS), D_MODEL ** -0.5),
        "q_norm": 1.0 + nrm(ks[7], (DEPTH, HEAD_DIM), 0.02),
        "k_norm": 1.0 + nrm(ks[8], (DEPTH, HEAD_DIM), 0.02),
        "conv_w": nrm(ks[9], (DEPTH, CONV_K, CONV_W), CONV_K ** -0.5),
        "gm_ln_g": 1.0 + nrm(ks[10], (DEPTH, GM_W), 0.02),
        "gm_ln_b": nrm(ks[11], (DEPTH, GM_W), 0.02),
        "gm_ws": nrm(ks[12], (DEPTH, GM_GROUPS, GM_CHUNK, GM_CHUNK), GM_CHUNK ** -0.5),
        "gm_b": 1.0 + nrm(ks[13], (DEPTH, GM_GROUPS, GM_CHUNK), 0.02),
        "w_br_attn": nrm(ks[14], (DEPTH, ATTN_W, D_MODEL), ATTN_W ** -0.5),
        "w_br_conv": nrm(ks[15], (DEPTH, CONV_W, D_MODEL), CONV_W ** -0.5),
        "w_br_gm": nrm(ks[16], (DEPTH, GM_W, D_MODEL), GM_W ** -0.5),
        "w_out": nrm(ks[17], (DEPTH, D_MODEL, D_MODEL), BETA * D_MODEL ** -0.5),
        "ln_g": 1.0 + nrm(ks[18], (DEPTH, D_MODEL), 0.02),
        "ln_b": nrm(ks[19], (DEPTH, D_MODEL), 0.02),
    }


def reference(x, c, ctx, c_ctx, w_ada, b_ada, w_in, q_norm, k_norm, conv_w, gm_ln_g, gm_ln_b,
              gm_ws, gm_b, w_br_attn, w_br_conv, w_br_gm, w_out, ln_g, ln_b):
    n = x.shape[1]
    rows = n // GRID_W
    rope = rope_2d_tables(rows)
    for l in range(DEPTH):
        last = l == DEPTH - 1
        sh_c, sc_c, gt_c = modulation(c_ctx, w_ada[l], b_ada[l])
        u_ctx = ctx * (1.0 + sc_c) + sh_c
        if last:
            k_raw, v_raw = jnp.split(u_ctx @ w_in[l][:, KV_START:KV_END], 2, axis=-1)
            k_c, v_c = kv_heads(k_raw, v_raw, k_norm[l], None)
        else:
            p_ctx = jnp.split(u_ctx @ w_in[l], IN_SPLIT_IDX, axis=-1)
            q_c = q_heads(p_ctx[0], q_norm[l], None)
            k_c, v_c = kv_heads(p_ctx[1], p_ctx[2], k_norm[l], None)
            out_c = mixer_sublayer(p_ctx, q_c, k_c, v_c, conv_w[l], gm_ln_g[l], gm_ln_b[l], gm_ws[l],
                                   gm_b[l], w_br_attn[l], w_br_conv[l], w_br_gm[l], w_out[l])
            new_ctx = layer_norm(ALPHA * ctx + gt_c * out_c, ln_g[l], ln_b[l])
        sh, sc, gt = modulation(c, w_ada[l], b_ada[l])
        u = x * (1.0 + sc[:, None]) + sh[:, None]
        p = jnp.split(u @ w_in[l], IN_SPLIT_IDX, axis=-1)
        q = q_heads(p[0], q_norm[l], rope)
        k, v = kv_heads(p[1], p[2], k_norm[l], rope)
        k_all = jnp.concatenate([k_c, k], axis=1)
        v_all = jnp.concatenate([v_c, v], axis=1)
        out = mixer_sublayer(p, q, k_all, v_all, conv_w[l], gm_ln_g[l], gm_ln_b[l], gm_ws[l],
                             gm_b[l], w_br_attn[l], w_br_conv[l], w_br_gm[l], w_out[l])
        x = layer_norm(ALPHA * x + gt[:, None] * out, ln_g[l], ln_b[l])
        if not last:
            ctx = new_ctx
    return x
```

```cpp
#include <hip/hip_runtime.h>
#include <hip/hip_bf16.h>
#include <cstdio>
#include <cstdint>
#include <cmath>

constexpr int DM = 4096, NB = 2, SEQ = 4096, CTXL = 256, DEPTH = 2;
constexpr int NLAT = NB * SEQ, NCTX = NB * CTXL, MT = NLAT + NCTX;
constexpr int HD = 128, NQH = 16, NKVH = 4, ATTN_W = 2048, KV_W = 512, CONV_W = 1024, GM_W = 1024;
constexpr int INC = 24576;
constexpr int C_Q = 0, C_K = 2048, C_V = 2560, C_AG = 3072, C_CB = 5120, C_CC = 6144, C_CH = 7168, C_CG = 8192, C_GU = 9216, C_GV = 10240, C_GG = 11264, C_MG = 12288;
constexpr int C_BF0 = 5120, C_BF1 = 12288, NI8 = INC - (C_BF1 - C_BF0);
constexpr int SKV = CTXL + SEQ;
constexpr float EPS = 1e-6f;
constexpr float ALPHA_RES = 1.4142135623730951f;

constexpr size_t MiB = 1u << 20;
constexpr size_t WS_CTL = 0, CTL_ZERO_BYTES = 1 * MiB;
constexpr size_t WS_ROPE = 1 * MiB;
constexpr size_t WS_MOD = 2 * MiB;
constexpr int NKC = 64;
constexpr size_t WS_MODP = 4 * MiB;
constexpr size_t WS_WIN = 32 * MiB, WIN_L = 192 * MiB;
constexpr size_t WS_WBR = 416 * MiB, WBR_L = 32 * MiB;
constexpr size_t WS_WOUT = 480 * MiB, WOUT_L = 32 * MiB;
constexpr size_t WS_U = 544 * MiB;
constexpr size_t WS_P = 612 * MiB;
constexpr size_t WS_Q = 1020 * MiB;
constexpr size_t WS_K = 1054 * MiB, WS_V = 1063 * MiB;
constexpr size_t WS_Y = 1072 * MiB;
constexpr size_t WS_MG = 1140 * MiB;
constexpr size_t WS_MGF = 1208 * MiB;
constexpr size_t WS_R = 1344 * MiB;
constexpr size_t WS_XC = 1480 * MiB;
constexpr size_t WS_U8 = 1616 * MiB;
constexpr size_t WS_W8 = 1652 * MiB, W8_L = 68 * MiB;
constexpr size_t WS_SU = 1790 * MiB;
constexpr size_t WS_SW = 1791 * MiB;
constexpr size_t WS_W8O = 1792 * MiB, W8O_L = 16 * MiB;
constexpr size_t WS_MG8 = 1824 * MiB;
constexpr size_t WS_PMAXO = 1858 * MiB;
constexpr size_t WS_SWO = 1861 * MiB;
constexpr size_t WS_SM = 1862 * MiB;
constexpr size_t WS_END = 1863 * MiB;
constexpr size_t CTL_RS = 327680;
constexpr size_t CTL_UMAX = 622592;
constexpr size_t CTL_PCNT2 = 671744;
constexpr size_t CTL_PCNT = 262144;
constexpr size_t CTL_ROWMAX = 131072;
constexpr size_t WS_PMAX = 22 * MiB;
constexpr int CW_BAR = 4096;

namespace pg8 {
#define PG8_LAS __attribute__((address_space(3)))
#define PG8_GAS __attribute__((address_space(1)))
typedef unsigned short bf16_t;
typedef short bf16x8 __attribute__((ext_vector_type(8)));
typedef float f32x4 __attribute__((ext_vector_type(4)));
typedef unsigned u32x4 __attribute__((ext_vector_type(4)));
constexpr int BM = 256, BK = 64, HALF = 128, HTB = HALF * BK * 2  , STAGE_BYTES = 8 * HTB, NXCD = 8, WGM = 4;

__host__ __device__ __forceinline__ int lds_byte(int r, int c) { const int st = (r >> 4) * 2 + (c >> 5), rr = r & 15, cc = c & 31, ob = rr * 64 + cc * 2; return st * 1024 + (ob ^ (((ob >> 9) & 1) << 5)); }
__host__ __device__ __forceinline__ void stage_rc(int b, int& R, int& C) { const int st = b / 1024, sb = b % 1024, swz = sb ^ (((sb >> 9) & 1) << 5); R = (st >> 1) * 16 + swz / 64; C = (st & 1) * 32 + (swz % 64) / 2; }
__host__ __device__ __forceinline__ int perm32(int rho) { const int n = rho >> 4, i = rho & 15; return 8 * (i >> 2) + 4 * n + (i & 3); }

struct Unit { int pm, pn; };
struct Gemm { const bf16_t* A; const bf16_t* Bt; int lda, ldb, K; };

struct Order {
    int nM, nN, nwg, G, c, nextra;
    int noremap = 0;
    int panel = 0;
    int full, rem, n3;
    __host__ __device__ void init(int nM_, int nN_, int G_, int c_, int nextra_, int n3_ = 0) { nM = nM_; nN = nN_; nwg = nM * nN; G = G_; c = c_; nextra = nextra_;
        const int tot = nwg + nextra; full = tot / G; rem = tot % G; n3 = n3_ > 0 ? n3_ : G; }
    int seg = 0, sn0 = 0, sw0 = 0, sn1 = 0, sw1 = 0, sn2 = 0, sw2 = 0;
    __host__ __device__ bool next(int i, Unit& u) const {
        long L;
        if (seg) { int w, base;
            if (i < sn0) { w = sw0; base = i * sw0; } else if (i < sn0 + sn1) { w = sw1; base = sn0 * sw0 + (i - sn0) * sw1; } else if (i < sn0 + sn1 + sn2) { w = sw2; base = sn0 * sw0 + sn1 * sw1 + (i - sn0 - sn1) * sw2; } else return false;
            if (c >= w) return false;
            L = base + c; if (L >= nwg + nextra) return false; }
        else if (i < full) L = (long)i * G + c;
        else { const int idx = (i - full) * n3 + c; if (c >= n3 || idx >= rem) return false; L = (long)full * G + idx; }
        if (L >= nwg) { const int e = (int)(L - nwg); u.pm = 32 + (e >> 2); u.pn = 8 + (e & 3); return true; }
        if (panel) { u.pm = (int)(L / nN); u.pn = (int)(L % nN); return true; }
        int wgid = (int)L; if (!noremap) { const int q = nwg / NXCD, r = nwg % NXCD, xcd = wgid % NXCD, off = wgid / NXCD; wgid = (xcd < r ? xcd * (q + 1) : r * (q + 1) + (xcd - r) * q) + off; }
        const int nig = WGM * nN, gid = wgid / nig, fm = gid * WGM, gsz = (nM - fm) < WGM ? (nM - fm) : WGM;
        u.pm = fm + ((wgid % nig) % gsz); u.pn = (wgid % nig) / gsz; return true;
    }
    __device__ __forceinline__ void a_ready(const Unit&) const {}
    __device__ __forceinline__ void done(const Unit&) const {}
};

typedef float f32x2_t_ __attribute__((ext_vector_type(2)));
typedef __bf16 bf16x2_t_ __attribute__((ext_vector_type(2)));
__device__ __forceinline__ unsigned cvt_pk_bf16(float lo, float hi) { const f32x2_t_ v = {lo, hi}; return __builtin_bit_cast(unsigned, __builtin_convertvector(v, bf16x2_t_)); }
__device__ __forceinline__ float bf_lo(unsigned w) { return __uint_as_float(w << 16); }
__device__ __forceinline__ float bf_hi(unsigned w) { return __uint_as_float(w & 0xffff0000u); }
__device__ __forceinline__ float sigmoidf_(float x) { return __builtin_amdgcn_rcpf(1.0f + __expf(-x)); }

struct EpiBf16 {
    static constexpr bool PERM = true, AFTER_DRAIN = false;
    bf16_t* O; int ldc; int sig_from;
    __device__ __forceinline__ void operator()(const f32x4 (&acc)[2][2][4][2], const Unit& u, int wr, int wc, int fr, int fq) const {
        const int row0 = u.pm * BM + wr * 64 + fr, col0 = u.pn * BM + wc * 32 + 8 * fq;
#pragma unroll
        for (int ai = 0; ai < 2; ++ai)
#pragma unroll
            for (int m = 0; m < 4; ++m) { bf16_t* rowp = O + (size_t)(row0 + ai * HALF + m * 16) * ldc + col0;
#pragma unroll
                for (int bj = 0; bj < 2; ++bj) { f32x4 v0 = acc[ai][bj][m][0], v1 = acc[ai][bj][m][1];
                    if (u.pn >= sig_from) {
#pragma unroll
                        for (int e = 0; e < 4; ++e) { v0[e] = sigmoidf_(v0[e]); v1[e] = sigmoidf_(v1[e]); } }
                    u32x4 w; w.x = cvt_pk_bf16(v0[0], v0[1]); w.y = cvt_pk_bf16(v0[2], v0[3]); w.z = cvt_pk_bf16(v1[0], v1[1]); w.w = cvt_pk_bf16(v1[2], v1[3]);
                    *(u32x4*)(rowp + bj * HALF) = w; } }
    }
};
__device__ __forceinline__ void panel_wait(PG8_GAS unsigned* pc, unsigned need, PG8_GAS unsigned* tmo, int wr, int wc, int lane_) {
    asm volatile("s_waitcnt vmcnt(0) lgkmcnt(0)" ::: "memory");
    if (lane_ == 0) __hip_atomic_fetch_add(pc, 1u, __ATOMIC_RELAXED, __HIP_MEMORY_SCOPE_AGENT);
    if (wr == 0 && wc == 0) { unsigned spins = 0;
        while ((unsigned)__builtin_amdgcn_readfirstlane(__hip_atomic_load(pc, __ATOMIC_RELAXED, __HIP_MEMORY_SCOPE_AGENT)) < need) {
            __builtin_amdgcn_s_sleep(1);
            if (++spins > (1u << 20)) { if (lane_ == 0) __hip_atomic_store(tmo, 1u, __ATOMIC_RELAXED, __HIP_MEMORY_SCOPE_AGENT); break; } } }
    asm volatile("" ::: "memory"); __builtin_amdgcn_s_barrier(); asm volatile("" ::: "memory");
}
struct EpiMerge {
    static constexpr bool PERM = true, AFTER_DRAIN = false, HAS_MID = true;
    static constexpr int SEAM0 = ATTN_W / BK, SEAM1 = (ATTN_W + CONV_W) / BK;
    const bf16_t* gate; int ldg; unsigned char* mg8; int ldc; unsigned* rowmax; unsigned* pcnt; unsigned need; float* sm; unsigned* tmo;
    __device__ __forceinline__ void seam_mul(f32x4 (&acc)[2][2][4][2], int ai, int m, int bj, const u32x4 a, const u32x4 b) const {
        f32x4 r0, r1;
        r0[0] = bf_lo(a.x) * __builtin_amdgcn_rcpf(fmaxf(bf_lo(b.x), 1e-6f)); r0[1] = bf_hi(a.x) * __builtin_amdgcn_rcpf(fmaxf(bf_hi(b.x), 1e-6f));
        r0[2] = bf_lo(a.y) * __builtin_amdgcn_rcpf(fmaxf(bf_lo(b.y), 1e-6f)); r0[3] = bf_hi(a.y) * __builtin_amdgcn_rcpf(fmaxf(bf_hi(b.y), 1e-6f));
        r1[0] = bf_lo(a.z) * __builtin_amdgcn_rcpf(fmaxf(bf_lo(b.z), 1e-6f)); r1[1] = bf_hi(a.z) * __builtin_amdgcn_rcpf(fmaxf(bf_hi(b.z), 1e-6f));
        r1[2] = bf_lo(a.w) * __builtin_amdgcn_rcpf(fmaxf(bf_lo(b.w), 1e-6f)); r1[3] = bf_hi(a.w) * __builtin_amdgcn_rcpf(fmaxf(bf_hi(b.w), 1e-6f));
        acc[ai][bj][m][0] *= r0; acc[ai][bj][m][1] *= r1;
    }
    __device__ __forceinline__ void mid(f32x4 (&acc)[2][2][4][2], const Unit& u, int seg, int wr, int wc, int fr, int fq) const {
        asm volatile("" : "+v"(fr), "+v"(fq));
        const int row0 = u.pm * BM + wr * 64 + fr, col0 = u.pn * BM + wc * 32 + 8 * fq;
        u32x4 ga[4][2], gb[4][2], ha[4][2], hb[4][2];
#pragma unroll
        for (int m = 0; m < 4; ++m) { const bf16_t* gp = gate + (size_t)(row0 + m * 16) * ldg + seg * DM + col0;
#pragma unroll
            for (int bj = 0; bj < 2; ++bj) { ga[m][bj] = *(const u32x4*)(gp + bj * HALF); gb[m][bj] = *(const u32x4*)(gp + DM + bj * HALF); } }
#pragma unroll
        for (int m = 0; m < 4; ++m) {
#pragma unroll
            for (int bj = 0; bj < 2; ++bj) seam_mul(acc, 0, m, bj, ga[m][bj], gb[m][bj]);
            const bf16_t* gp = gate + (size_t)(row0 + HALF + m * 16) * ldg + seg * DM + col0;
#pragma unroll
            for (int bj = 0; bj < 2; ++bj) { ha[m][bj] = *(const u32x4*)(gp + bj * HALF); hb[m][bj] = *(const u32x4*)(gp + DM + bj * HALF); } }
#pragma unroll
        for (int m = 0; m < 4; ++m)
#pragma unroll
            for (int bj = 0; bj < 2; ++bj) seam_mul(acc, 1, m, bj, ha[m][bj], hb[m][bj]);
    }
    __device__ __forceinline__ void operator()(const f32x4 (&acc)[2][2][4][2], const Unit& u, int wr, int wc, int fr, int fq) const {
        const int row0 = u.pm * BM + wr * 64 + fr, col0 = u.pn * BM + wc * 32 + 8 * fq;
        f32x4 v[2][2][4][2];
#pragma unroll
        for (int ai = 0; ai < 2; ++ai) { u32x4 gl[4][2];
#pragma unroll
            for (int m = 0; m < 4; ++m)
#pragma unroll
                for (int bj = 0; bj < 2; ++bj) gl[m][bj] = *(const u32x4*)(gate + (size_t)(row0 + ai * HALF + m * 16) * ldg + 2 * DM + col0 + bj * HALF);
#pragma unroll
            for (int m = 0; m < 4; ++m) { const size_t row = (size_t)(row0 + ai * HALF + m * 16); float rmx = 0.f;
#pragma unroll
                for (int bj = 0; bj < 2; ++bj) { const int col = col0 + bj * HALF;
                    const u32x4 gv = gl[m][bj];
                    f32x4 g0, g1;
                    g0[0] = fmaxf(bf_lo(gv.x), 1e-6f); g0[1] = fmaxf(bf_hi(gv.x), 1e-6f); g0[2] = fmaxf(bf_lo(gv.y), 1e-6f); g0[3] = fmaxf(bf_hi(gv.y), 1e-6f);
                    g1[0] = fmaxf(bf_lo(gv.z), 1e-6f); g1[1] = fmaxf(bf_hi(gv.z), 1e-6f); g1[2] = fmaxf(bf_lo(gv.w), 1e-6f); g1[3] = fmaxf(bf_hi(gv.w), 1e-6f);
                    v[ai][bj][m][0] = acc[ai][bj][m][0] * g0; v[ai][bj][m][1] = acc[ai][bj][m][1] * g1;
#pragma unroll
                    for (int e = 0; e < 4; ++e) rmx = fmaxf(rmx, fmaxf(__builtin_fabsf(v[ai][bj][m][0][e]), __builtin_fabsf(v[ai][bj][m][1][e]))); }
                rmx = fmaxf(rmx, __shfl_xor(rmx, 16)); rmx = fmaxf(rmx, __shfl_xor(rmx, 32));
                if (fq == 0) __hip_atomic_fetch_max((PG8_GAS unsigned*)rowmax + row, __float_as_uint(rmx), __ATOMIC_RELAXED, __HIP_MEMORY_SCOPE_AGENT); } }
        panel_wait((PG8_GAS unsigned*)pcnt + 64 * u.pm, need, (PG8_GAS unsigned*)tmo, wr, wc, fr + 16 * fq);
        float mx8[2][4];
#pragma unroll
        for (int ai = 0; ai < 2; ++ai)
#pragma unroll
            for (int m = 0; m < 4; ++m) mx8[ai][m] = __uint_as_float(__hip_atomic_load((PG8_GAS unsigned*)rowmax + (size_t)(row0 + ai * HALF + m * 16), __ATOMIC_RELAXED, __HIP_MEMORY_SCOPE_AGENT));
#pragma unroll
        for (int ai = 0; ai < 2; ++ai)
#pragma unroll
            for (int m = 0; m < 4; ++m) { const size_t row = (size_t)(row0 + ai * HALF + m * 16);
                const float mx = mx8[ai][m];
                const float sc = mx > 0.f ? mx * (1.0f / 127.0f) : 1.0f, inv = 1.0f / sc;
                if (u.pn == 0 && wc == 0 && fq == 0) __hip_atomic_store((PG8_GAS float*)sm + row, sc, __ATOMIC_RELAXED, __HIP_MEMORY_SCOPE_AGENT);
#pragma unroll
                for (int bj = 0; bj < 2; ++bj) { int q[8];
#pragma unroll
                    for (int e = 0; e < 4; ++e) { q[e] = __float2int_rn(v[ai][bj][m][0][e] * inv); q[4 + e] = __float2int_rn(v[ai][bj][m][1][e] * inv); }
                    unsigned w0 = (unsigned)(q[0] & 255) | ((unsigned)(q[1] & 255) << 8) | ((unsigned)(q[2] & 255) << 16) | ((unsigned)(q[3] & 255) << 24);
                    unsigned w1 = (unsigned)(q[4] & 255) | ((unsigned)(q[5] & 255) << 8) | ((unsigned)(q[6] & 255) << 16) | ((unsigned)(q[7] & 255) << 24);
                    typedef unsigned u32x2_ __attribute__((ext_vector_type(2)));
                    *(u32x2_*)(mg8 + row * ldc + col0 + bj * HALF) = (u32x2_){w0, w1}; } }
    }
};
typedef int i32x4 __attribute__((ext_vector_type(4)));
template <class E, class = void> struct HasMid { static constexpr bool value = false; };
template <class E> struct HasMid<E, decltype((void)E::HAS_MID)> { static constexpr bool value = E::HAS_MID; };
template <bool I8> struct AccT;
template <> struct AccT<false> { typedef f32x4 type; static __device__ __forceinline__ f32x4 zero() { return (f32x4){0.f, 0.f, 0.f, 0.f}; } };
template <> struct AccT<true>  { typedef i32x4 type; static __device__ __forceinline__ i32x4 zero() { return (i32x4){0, 0, 0, 0}; } };
template <bool I8> __device__ __forceinline__ void mma1(typename AccT<I8>::type& c, const bf16x8& a, const bf16x8& b);
template <> __device__ __forceinline__ void mma1<false>(f32x4& c, const bf16x8& a, const bf16x8& b) { c = __builtin_amdgcn_mfma_f32_16x16x32_bf16(a, b, c, 0, 0, 0); }
template <> __device__ __forceinline__ void mma1<true>(i32x4& c, const bf16x8& a, const bf16x8& b) { c = __builtin_amdgcn_mfma_i32_16x16x64_i8(__builtin_bit_cast(i32x4, a), __builtin_bit_cast(i32x4, b), c, 0, 0, 0); }
struct EpiGateI8 {
    static constexpr bool PERM = true, AFTER_DRAIN = false;
    bf16_t* O; int ldc; const float* su; const float* sw;
    __device__ __forceinline__ void operator()(const i32x4 (&acc)[2][2][4][2], const Unit& u, int wr, int wc, int fr, int fq) const {
        const bool gate = u.pn >= C_BF0 / 256;
        const int row0 = u.pm * BM + wr * 64 + fr, cw = u.pn * BM + wc * 32 + 8 * fq, col0 = cw + (gate ? (C_BF1 - C_BF0) : 0);
        f32x4 cs[2][2];
#pragma unroll
        for (int bj = 0; bj < 2; ++bj)
#pragma unroll
            for (int n = 0; n < 2; ++n) { cs[bj][n] = *(const f32x4*)(sw + cw + bj * HALF + 4 * n); if (gate) cs[bj][n] *= -1.4426950408889634f; }
        float rs8[2][4];
#pragma unroll
        for (int ai = 0; ai < 2; ++ai)
#pragma unroll
            for (int m = 0; m < 4; ++m) rs8[ai][m] = su[row0 + ai * HALF + m * 16];
#pragma unroll
        for (int ai = 0; ai < 2; ++ai)
#pragma unroll
            for (int m = 0; m < 4; ++m) { const int row = row0 + ai * HALF + m * 16; const float rs = rs8[ai][m]; bf16_t* rowp = O + (size_t)row * ldc + col0;
#pragma unroll
                for (int bj = 0; bj < 2; ++bj) { f32x4 v0, v1;
#pragma unroll
                    for (int e = 0; e < 4; ++e) { v0[e] = (float)acc[ai][bj][m][0][e] * rs * cs[bj][0][e]; v1[e] = (float)acc[ai][bj][m][1][e] * rs * cs[bj][1][e]; }
                    if (gate) {
#pragma unroll
                        for (int e = 0; e < 4; ++e) { v0[e] = __builtin_amdgcn_rcpf(1.0f + __builtin_amdgcn_exp2f(v0[e])); v1[e] = __builtin_amdgcn_rcpf(1.0f + __builtin_amdgcn_exp2f(v1[e])); } }
                    u32x4 w; w.x = cvt_pk_bf16(v0[0], v0[1]); w.y = cvt_pk_bf16(v0[2], v0[3]); w.z = cvt_pk_bf16(v1[0], v1[1]); w.w = cvt_pk_bf16(v1[2], v1[3]);
                    *(u32x4*)(rowp + bj * HALF) = w; } }
    }
};

template <bool XBF, bool LAST> struct EpiResLnI8 {
    static constexpr bool PERM = true, AFTER_DRAIN = false;
    unsigned char* ws; int l; const void* xlat; const void* xctx; const float* lg; const float* lb; float* out;
    __device__ __forceinline__ void operator()(i32x4 (&acc)[2][2][4][2], const Unit& u, int wr, int wc, int fr, int fq) const {
        asm volatile("" : "+v"(fr), "+v"(fq));
        unsigned char* w_ = ws; int l_ = l; asm volatile("" : "+s"(w_), "+s"(l_));
        PG8_GAS unsigned char* wg = (PG8_GAS unsigned char*)w_;
        const PG8_GAS float* modv = (const PG8_GAS float*)(wg + WS_MOD) + l_ * 3 * 12288; const PG8_GAS float* mod1 = (const PG8_GAS float*)(wg + WS_MOD) + 3 * 12288; const float alpha = ALPHA_RES;
        const PG8_GAS float* sm = (const PG8_GAS float*)(wg + WS_SM); const PG8_GAS float* swo = (const PG8_GAS float*)(wg + WS_SWO) + l_ * DM;
        PG8_GAS bf16_t* xc = (PG8_GAS bf16_t*)(wg + WS_XC); PG8_GAS bf16_t* U = (PG8_GAS bf16_t*)(wg + WS_U); PG8_GAS unsigned char* U8 = wg + WS_U8; PG8_GAS float* su = (PG8_GAS float*)(wg + WS_SU);
        PG8_GAS unsigned long long* rs = (PG8_GAS unsigned long long*)(wg + WS_CTL + CTL_RS) + (size_t)l_ * 2 * MT; PG8_GAS unsigned* umax = (PG8_GAS unsigned*)(wg + WS_CTL + CTL_UMAX);
        PG8_GAS unsigned* pcnt = (PG8_GAS unsigned*)(wg + WS_CTL + CTL_PCNT2) + (l_ * 2 + 0) * 64 * 64; PG8_GAS unsigned* pcnt2 = (PG8_GAS unsigned*)(wg + WS_CTL + CTL_PCNT2) + (l_ * 2 + 1) * 64 * 64;
        PG8_GAS unsigned* tmo = (PG8_GAS unsigned*)(wg + WS_CTL) + 2; const unsigned need = 16u * 8u;
        const PG8_GAS float* lgp = (const PG8_GAS float*)lg; const PG8_GAS float* lbp = (const PG8_GAS float*)lb; PG8_GAS float* outp = (PG8_GAS float*)out;
        const int row0 = u.pm * BM + wr * 64 + fr, col0 = u.pn * BM + wc * 32 + 8 * fq, lane_ = fr + 16 * fq;
        const int which = u.pm < 16 ? 0 : (u.pm < 32 ? 1 : 2);
        const PG8_GAS float* gt = modv + which * 12288 + 8192;
#define RR(ai, bj, m, n) __builtin_bit_cast(f32x4, acc[ai][bj][m][n])
#define RW(ai, bj, m, n, v) acc[ai][bj][m][n] = __builtin_bit_cast(i32x4, (v))
        {   f32x4 gv[2][2];
#pragma unroll
            for (int bj = 0; bj < 2; ++bj)
#pragma unroll
                for (int n = 0; n < 2; ++n) gv[bj][n] = *(const PG8_GAS f32x4*)(gt + col0 + bj * HALF + 4 * n) * *(const PG8_GAS f32x4*)(swo + col0 + bj * HALF + 4 * n);
#pragma unroll
            for (int ai = 0; ai < 2; ++ai)
#pragma unroll
            for (int mh = 0; mh < (XBF ? 1 : 2); ++mh) {
              constexpr int MB = XBF ? 4 : 2;
              const PG8_GAS void* xb = (const PG8_GAS void*)((u.pm < 32) ? xlat : xctx);
              float rsc4[MB]; u32x4 xq[MB][2]; f32x4 xf[XBF ? 1 : MB][XBF ? 1 : 2][2];
#pragma unroll
              for (int mm = 0; mm < MB; ++mm) { const int m = mh * MB + mm; const int row = row0 + ai * HALF + m * 16; rsc4[mm] = sm[row];
                  const size_t xoff = (u.pm < 32) ? (size_t)row * DM : (size_t)(row - 8192) * DM;
#pragma unroll
                  for (int bj = 0; bj < 2; ++bj) { const int col = col0 + bj * HALF;
                      if (XBF) xq[mm][bj] = *(const PG8_GAS u32x4*)((const PG8_GAS bf16_t*)xb + xoff + col);
                      else { xf[XBF ? 0 : mm][XBF ? 0 : bj][0] = *(const PG8_GAS f32x4*)((const PG8_GAS float*)xb + xoff + col); xf[XBF ? 0 : mm][XBF ? 0 : bj][1] = *(const PG8_GAS f32x4*)((const PG8_GAS float*)xb + xoff + col + 4); } } }
#pragma unroll
                for (int mm = 0; mm < MB; ++mm) { const int m = mh * MB + mm; const int row = row0 + ai * HALF + m * 16; const float rsc = rsc4[mm];
                    float s1 = 0.f, s2 = 0.f;
#pragma unroll
                    for (int bj = 0; bj < 2; ++bj) { f32x4 x0, x1;
                        if (XBF) { const u32x4 xv = xq[mm][bj];
                            x0[0] = bf_lo(xv.x); x0[1] = bf_hi(xv.x); x0[2] = bf_lo(xv.y); x0[3] = bf_hi(xv.y); x1[0] = bf_lo(xv.z); x1[1] = bf_hi(xv.z); x1[2] = bf_lo(xv.w); x1[3] = bf_hi(xv.w); }
                        else { x0 = xf[XBF ? 0 : mm][XBF ? 0 : bj][0]; x1 = xf[XBF ? 0 : mm][XBF ? 0 : bj][1]; }
                        f32x4 a0, a1;
#pragma unroll
                        for (int e = 0; e < 4; ++e) { a0[e] = (float)acc[ai][bj][m][0][e]; a1[e] = (float)acc[ai][bj][m][1][e]; }
                        const f32x4 r0 = x0 * alpha + gv[bj][0] * rsc * a0, r1 = x1 * alpha + gv[bj][1] * rsc * a1;
                        RW(ai, bj, m, 0, r0); RW(ai, bj, m, 1, r1);
#pragma unroll
                        for (int e = 0; e < 4; ++e) { s1 += r0[e] + r1[e]; s2 += r0[e] * r0[e] + r1[e] * r1[e]; } }
                    s1 += __shfl_xor(s1, 16); s1 += __shfl_xor(s1, 32); s2 += __shfl_xor(s2, 16); s2 += __shfl_xor(s2, 32);
                    if (fq == 0) { __hip_atomic_fetch_add(rs + row, (unsigned long long)(long long)__float2ll_rn(s1 * 1048576.0f), __ATOMIC_RELAXED, __HIP_MEMORY_SCOPE_AGENT); __hip_atomic_fetch_add(rs + MT + row, (unsigned long long)(long long)__float2ll_rn(s2 * 4096.0f), __ATOMIC_RELAXED, __HIP_MEMORY_SCOPE_AGENT); } }  } }
        panel_wait(pcnt + 64 * u.pm, need, tmo, wr, wc, lane_);
        float mean[8], rstd[8];
        unsigned long long sv1[8], sv2[8];
#pragma unroll
        for (int ai = 0; ai < 2; ++ai)
#pragma unroll
            for (int m = 0; m < 4; ++m) { const int row = row0 + ai * HALF + m * 16;
                sv1[ai * 4 + m] = __hip_atomic_load(rs + row, __ATOMIC_RELAXED, __HIP_MEMORY_SCOPE_AGENT); sv2[ai * 4 + m] = __hip_atomic_load(rs + MT + row, __ATOMIC_RELAXED, __HIP_MEMORY_SCOPE_AGENT); }
#pragma unroll
        for (int ai = 0; ai < 2; ++ai)
#pragma unroll
            for (int m = 0; m < 4; ++m) {
                const float S1 = (float)(long long)sv1[ai * 4 + m] * (1.0f / 1048576.0f), S2 = (float)(long long)sv2[ai * 4 + m] * (1.0f / 4096.0f);
                const float mu = S1 * (1.0f / DM); mean[ai * 4 + m] = mu; rstd[ai * 4 + m] = 1.0f / sqrtf(fmaxf(S2 * (1.0f / DM) - mu * mu, 0.f) + EPS); }
        typedef unsigned u32x2_ __attribute__((ext_vector_type(2)));
#pragma unroll
        for (int bj = 0; bj < 2; ++bj) {
            f32x4 gS[2], bS[2], cS[LAST ? 1 : 2], hS[LAST ? 1 : 2];
#pragma unroll
            for (int n = 0; n < 2; ++n) { const int col = col0 + bj * HALF + 4 * n;
                gS[n] = *(const PG8_GAS f32x4*)(lgp + col); bS[n] = *(const PG8_GAS f32x4*)(lbp + col);
                if (!LAST) { const PG8_GAS float* m1 = mod1 + which * 12288; cS[LAST ? 0 : n] = *(const PG8_GAS f32x4*)(m1 + DM + col); hS[LAST ? 0 : n] = *(const PG8_GAS f32x4*)(m1 + col); } }
#pragma unroll
            for (int n = 0; n < 2; ++n) { const int col = col0 + bj * HALF + 4 * n;
                const f32x4 g = gS[n], b = bS[n];
                f32x4 cc = g, hh = g;
                if (!LAST) { cc = cS[LAST ? 0 : n] + 1.0f; hh = hS[LAST ? 0 : n]; }
#pragma unroll
                for (int ai = 0; ai < 2; ++ai)
#pragma unroll
                    for (int m = 0; m < 4; ++m) { const unsigned eo = (unsigned)(row0 + ai * HALF + m * 16) * (unsigned)DM + (unsigned)col;
                        const f32x4 nn = (RR(ai, bj, m, n) - mean[ai * 4 + m]) * rstd[ai * 4 + m] * g + b;
                        if (LAST) *(PG8_GAS f32x4*)(outp + eo) = nn;
                        else { u32x2_ w; w.x = cvt_pk_bf16(nn[0], nn[1]); w.y = cvt_pk_bf16(nn[2], nn[3]); *(PG8_GAS u32x2_*)(xc + eo) = w;
                            const f32x4 uu = nn * cc + hh; RW(ai, bj, m, n, uu);
                            w.x = cvt_pk_bf16(uu[0], uu[1]); w.y = cvt_pk_bf16(uu[2], uu[3]); *(PG8_GAS u32x2_*)(U + eo) = w; } } } }
        if (!LAST) {
#pragma unroll
            for (int ai = 0; ai < 2; ++ai)
#pragma unroll
                for (int m = 0; m < 4; ++m) { float mx = 0.f;
#pragma unroll
                    for (int bj = 0; bj < 2; ++bj)
#pragma unroll
                        for (int n = 0; n < 2; ++n)
#pragma unroll
                            for (int e = 0; e < 4; ++e) mx = fmaxf(mx, __builtin_fabsf(RR(ai, bj, m, n)[e]));
                    mx = fmaxf(mx, __shfl_xor(mx, 16)); mx = fmaxf(mx, __shfl_xor(mx, 32));
                    if (fq == 0) __hip_atomic_fetch_max(umax + row0 + ai * HALF + m * 16, __float_as_uint(mx), __ATOMIC_RELAXED, __HIP_MEMORY_SCOPE_AGENT); }
            panel_wait(pcnt2 + 64 * u.pm, need, tmo, wr, wc, lane_);
            float umx8[2][4];
#pragma unroll
            for (int ai = 0; ai < 2; ++ai)
#pragma unroll
                for (int m = 0; m < 4; ++m) umx8[ai][m] = __uint_as_float(__hip_atomic_load(umax + (unsigned)(row0 + ai * HALF + m * 16), __ATOMIC_RELAXED, __HIP_MEMORY_SCOPE_AGENT));
#pragma unroll
            for (int ai = 0; ai < 2; ++ai)
#pragma unroll
                for (int m = 0; m < 4; ++m) { const unsigned row = (unsigned)(row0 + ai * HALF + m * 16);
                    const float mx = umx8[ai][m];
                    const float sc = mx > 0.f ? mx * (1.0f / 127.0f) : 1.0f, inv = 1.0f / sc;
                    if (u.pn == 0 && wc == 0 && fq == 0) __hip_atomic_store(su + row, sc, __ATOMIC_RELAXED, __HIP_MEMORY_SCOPE_AGENT);
#pragma unroll
                    for (int bj = 0; bj < 2; ++bj) { int q[8];
#pragma unroll
                        for (int e = 0; e < 4; ++e) { q[e] = __float2int_rn(RR(ai, bj, m, 0)[e] * inv); q[4 + e] = __float2int_rn(RR(ai, bj, m, 1)[e] * inv); }
                        const unsigned w0 = (unsigned)(q[0] & 255) | ((unsigned)(q[1] & 255) << 8) | ((unsigned)(q[2] & 255) << 16) | ((unsigned)(q[3] & 255) << 24);
                        const unsigned w1 = (unsigned)(q[4] & 255) | ((unsigned)(q[5] & 255) << 8) | ((unsigned)(q[6] & 255) << 16) | ((unsigned)(q[7] & 255) << 24);
                        *(PG8_GAS u32x2_*)(U8 + (row * (unsigned)DM + (unsigned)(col0 + bj * HALF))) = (u32x2_){w0, w1}; } }
        }
    }
};
#undef RR
#undef RW
template <class Epi, class Sched, bool ALIGN_EPI = false, bool SP2 = false, bool I8 = false>
__device__ __forceinline__ void gemm_phase(PG8_LAS unsigned char* lds, const Gemm g, const Sched& S, const Epi& E, const int tid) {
    const int wid = __builtin_amdgcn_readfirstlane(tid >> 6), lane = tid & 63, wr = wid >> 2, wc = wid & 3, fr = lane & 15, fq = lane >> 4;
    const int K = g.K, nt = K / BK;
    unsigned voffA[2], voffB[2];
#pragma unroll
    for (int i = 0; i < 2; ++i) { int R, C; stage_rc(tid * 16 + i * 8192, R, C); const int Rb = Epi::PERM ? ((R & ~31) + perm32(R & 31)) : R;
        voffA[i] = (unsigned)(R * g.lda + C) * 2u; voffB[i] = (unsigned)(Rb * g.ldb + C) * 2u; }
    const size_t kstep = (size_t)(BK * 2);
    const size_t hstepA = (size_t)HALF * g.lda * 2, hstepB = (size_t)HALF * g.ldb * 2;
    const size_t tstepA = 2 * hstepA, tstepB = 2 * hstepB;
    const unsigned ldsw = (unsigned)wid * 1024u;
    const int aoff = lds_byte(wr * 64 + fr, fq * 8), boff = lds_byte(wc * 32 + fr, fq * 8);
#define PG8_SA(b, h) (((b) * 2 + (h)) * HTB)
#define PG8_SB(b, h) ((4 + (b) * 2 + (h)) * HTB)
#define PG8_STAGE(bufoff, gbase, voff) do { _Pragma("unroll") for (int _i = 0; _i < 2; ++_i) \
        __builtin_amdgcn_global_load_lds((const unsigned*)((const char*)(gbase) + (voff)[_i]), (PG8_LAS unsigned*)(lds + (bufoff) + ldsw + _i * 8192), 16, 0, 0); } while (0)
#define PG8_LDA(dst, b, h) do { _Pragma("unroll") for (int m = 0; m < 4; ++m) _Pragma("unroll") for (int k = 0; k < 2; ++k) dst[m][k] = *(const PG8_LAS bf16x8*)(lds + PG8_SA(b, h) + aoff + m * 2048 + k * 1024); } while (0)
#define PG8_LDB(dst, b, h) do { _Pragma("unroll") for (int n = 0; n < 2; ++n) _Pragma("unroll") for (int k = 0; k < 2; ++k) dst[n][k] = *(const PG8_LAS bf16x8*)(lds + PG8_SB(b, h) + boff + n * 2048 + k * 1024); } while (0)
#define PG8_MMA(ai, bj, At, Bt) do { __builtin_amdgcn_s_setprio(1); _Pragma("unroll") for (int m = 0; m < 4; ++m) _Pragma("unroll") for (int n = 0; n < 2; ++n) _Pragma("unroll") for (int k = 0; k < 2; ++k) \
        mma1<I8>(acc[ai][bj][m][n], Bt[n][k], At[m][k]); __builtin_amdgcn_s_setprio(0); } while (0)
#define PG8_WAIT_V(n) asm volatile("s_waitcnt vmcnt(" #n ")" ::: "memory")
#define PG8_WAIT_L(n) asm volatile("s_waitcnt lgkmcnt(" #n ")" ::: "memory")
#define PG8_BAR __builtin_amdgcn_s_barrier()
#define PG8_SCHED __builtin_amdgcn_sched_barrier(0)
    Unit cur, nxt; int ui = 0;
    if (!S.next(0, cur)) return;
    typename AccT<I8>::type acc[2][2][4][2];
#pragma unroll
    for (int a = 0; a < 2; ++a)
#pragma unroll
        for (int b = 0; b < 2; ++b)
#pragma unroll
            for (int m = 0; m < 4; ++m)
#pragma unroll
                for (int n = 0; n < 2; ++n) acc[a][b][m][n] = AccT<I8>::zero();
    bf16x8 At[4][2], B0[2][2], B1[2][2];
    const char* cA = (const char*)g.A + (size_t)cur.pm * tstepA; const char* cB = (const char*)g.Bt + (size_t)cur.pn * tstepB;
    S.a_ready(cur);
    if constexpr (SP2) {
        PG8_STAGE(PG8_SB(0, 0), cB, voffB); PG8_STAGE(PG8_SB(0, 1), cB + hstepB, voffB); PG8_STAGE(PG8_SA(0, 0), cA, voffA); PG8_STAGE(PG8_SA(0, 1), cA + hstepA, voffA);
        if (wr == 1) PG8_BAR;
        PG8_WAIT_V(2); PG8_BAR;
        PG8_STAGE(PG8_SB(1, 0), cB + kstep, voffB); PG8_STAGE(PG8_SA(1, 0), cA + kstep, voffA); PG8_STAGE(PG8_SB(1, 1), cB + hstepB + kstep, voffB);
        PG8_WAIT_V(6); PG8_BAR;
    } else {
        PG8_STAGE(PG8_SB(0, 0), cB, voffB); PG8_STAGE(PG8_SA(0, 0), cA, voffA); PG8_STAGE(PG8_SB(0, 1), cB + hstepB, voffB); PG8_STAGE(PG8_SA(0, 1), cA + hstepA, voffA);
        if (wr == 1) PG8_BAR;
        PG8_WAIT_V(4); PG8_BAR;
        PG8_STAGE(PG8_SB(1, 0), cB + kstep, voffB); PG8_STAGE(PG8_SA(1, 0), cA + kstep, voffA); PG8_STAGE(PG8_SB(1, 1), cB + hstepB + kstep, voffB);
        PG8_WAIT_V(6); PG8_BAR;
    }
    for (;;) {
        const bool has_next = S.next(ui + 1, nxt);
        const char* nA = has_next ? (const char*)g.A + (size_t)nxt.pm * tstepA : cA; const char* nB = has_next ? (const char*)g.Bt + (size_t)nxt.pn * tstepB : cB;
        for (int t = 0; t < nt; t += 2) {
            const bool last = (t == nt - 2);
            const char* a1 = cA + (size_t)(t + 1) * kstep;
            const char* a2 = last ? nA : cA + (size_t)(t + 2) * kstep; const char* b2 = last ? nB : cB + (size_t)(t + 2) * kstep;
            const char* a3 = a2 + kstep; const char* b3 = b2 + kstep;
            if (last && has_next) S.a_ready(nxt);
            if constexpr (SP2) {
            PG8_LDB(B0, 0, 0); PG8_LDB(B1, 0, 1); PG8_SCHED; PG8_LDA(At, 0, 0); PG8_STAGE(PG8_SA(1, 1), a1 + hstepA, voffA);
            PG8_WAIT_V(8); PG8_WAIT_L(0); PG8_BAR; PG8_MMA(0, 0, At, B0); PG8_MMA(0, 1, At, B1); PG8_BAR; PG8_SCHED;
            PG8_LDA(At, 0, 1); PG8_STAGE(PG8_SB(0, 0), b2, voffB); PG8_STAGE(PG8_SB(0, 1), b2 + hstepB, voffB); PG8_STAGE(PG8_SA(0, 0), a2, voffA);
            PG8_WAIT_V(8); PG8_WAIT_L(0); PG8_BAR; PG8_MMA(1, 0, At, B0); PG8_MMA(1, 1, At, B1); PG8_BAR; PG8_SCHED;
            PG8_LDB(B0, 1, 0); PG8_LDB(B1, 1, 1); PG8_SCHED; PG8_LDA(At, 1, 0); PG8_STAGE(PG8_SA(0, 1), a2 + hstepA, voffA);
            PG8_WAIT_V(8); PG8_WAIT_L(0); PG8_BAR; PG8_MMA(0, 0, At, B0); PG8_MMA(0, 1, At, B1); PG8_BAR; PG8_SCHED;
            PG8_LDA(At, 1, 1); PG8_STAGE(PG8_SB(1, 0), b3, voffB); PG8_STAGE(PG8_SB(1, 1), b3 + hstepB, voffB); PG8_STAGE(PG8_SA(1, 0), a3, voffA);
            PG8_WAIT_V(8); PG8_WAIT_L(0); PG8_BAR; PG8_MMA(1, 0, At, B0); PG8_MMA(1, 1, At, B1); PG8_BAR; PG8_SCHED;
            if constexpr (HasMid<Epi>::value) { if (t + 2 == Epi::SEAM0 || t + 2 == Epi::SEAM1) E.mid(acc, cur, t + 2 == Epi::SEAM0 ? 0 : 1, wr, wc, fr, fq); }
            } else {
            PG8_LDB(B0, 0, 0); PG8_SCHED; PG8_LDA(At, 0, 0); PG8_STAGE(PG8_SA(1, 1), a1 + hstepA, voffA);
            PG8_WAIT_L(8); PG8_BAR; PG8_WAIT_L(0); PG8_MMA(0, 0, At, B0); PG8_BAR; PG8_SCHED;
            PG8_LDB(B1, 0, 1); PG8_STAGE(PG8_SB(0, 0), b2, voffB);
            PG8_BAR; PG8_WAIT_L(0); PG8_MMA(0, 1, At, B1); PG8_BAR;
            PG8_LDA(At, 0, 1); PG8_STAGE(PG8_SA(0, 0), a2, voffA);
            PG8_BAR; PG8_WAIT_L(0); PG8_MMA(1, 0, At, B0); PG8_BAR; PG8_SCHED;
            PG8_STAGE(PG8_SB(0, 1), b2 + hstepB, voffB);
            PG8_WAIT_V(6); PG8_BAR; PG8_MMA(1, 1, At, B1); PG8_BAR;
            PG8_LDB(B0, 1, 0); PG8_SCHED; PG8_LDA(At, 1, 0); PG8_STAGE(PG8_SA(0, 1), a2 + hstepA, voffA);
            PG8_WAIT_L(8); PG8_BAR; PG8_WAIT_L(0); PG8_MMA(0, 0, At, B0); PG8_BAR; PG8_SCHED;
            PG8_LDB(B1, 1, 1); PG8_STAGE(PG8_SB(1, 0), b3, voffB);
            PG8_BAR; PG8_WAIT_L(0); PG8_MMA(0, 1, At, B1); PG8_BAR;
            PG8_LDA(At, 1, 1); PG8_STAGE(PG8_SA(1, 0), a3, voffA);
            PG8_BAR; PG8_WAIT_L(0); PG8_MMA(1, 0, At, B0); PG8_BAR; PG8_SCHED;
            PG8_STAGE(PG8_SB(1, 1), b3 + hstepB, voffB);
            PG8_WAIT_V(6); PG8_BAR; PG8_MMA(1, 1, At, B1); PG8_BAR;
            }
        }
        if constexpr (ALIGN_EPI) { if (wr == 0) PG8_BAR; }
        if constexpr (!Epi::AFTER_DRAIN) { E(acc, cur, wr, wc, fr, fq); S.done(cur); }
        if (!has_next) break;
#pragma unroll
        for (int a = 0; a < 2; ++a)
#pragma unroll
            for (int b = 0; b < 2; ++b)
#pragma unroll
                for (int m = 0; m < 4; ++m)
#pragma unroll
                    for (int n = 0; n < 2; ++n) acc[a][b][m][n] = AccT<I8>::zero();
        cur = nxt; cA = nA; cB = nB; ++ui;
        if constexpr (ALIGN_EPI) { if (wr == 1) PG8_BAR; }
    }
    PG8_WAIT_V(0);
    if constexpr (!ALIGN_EPI) { if (wr == 0) PG8_BAR; }
    PG8_BAR;
    if constexpr (Epi::AFTER_DRAIN) { E.fused(acc, cur, wr, wc, fr, fq, lds, wid, lane); S.done(cur); }
#undef PG8_SA
#undef PG8_SB
#undef PG8_STAGE
#undef PG8_LDA
#undef PG8_LDB
#undef PG8_MMA
#undef PG8_WAIT_V
#undef PG8_WAIT_L
#undef PG8_BAR
#undef PG8_SCHED
}
}

namespace attn {
using bf16 = __hip_bfloat16;
constexpr int   D = 128, NW = 8, QBLK = 32, KVBLK = 64;
constexpr float SCALE = 0.088388347648318440f;
constexpr float THR = 8.f;
constexpr int SDEPTH = 2;
constexpr int LDQ = 2048, LDK = 512, LDG = 24576, LDY = 4096;
constexpr size_t SHM_V = KVBLK * D * 2, SHM_K = KVBLK * D * 2, SHM_ATTN = 2 * SHM_V + 2 * SHM_K + NW * 64 * 4;
using bf16x8 = __attribute__((ext_vector_type(8))) short;
using s16x4  = __attribute__((ext_vector_type(4))) short;
using f32x16 = __attribute__((ext_vector_type(16))) float;
using f32x8  = __attribute__((ext_vector_type(8))) float;
using u32x4  = __attribute__((ext_vector_type(4))) unsigned;
#define KSWZ(row, colB) ((row) * 256 + ((colB) ^ (((row) & 7) << 4)))
#define SBAR() __builtin_amdgcn_sched_barrier(0)
__device__ __forceinline__ int crow(int r, int hi) { return (r & 3) + 8 * (r >> 2) + 4 * hi; }
__device__ __forceinline__ unsigned cvtpk(float lo, float hi) { return pg8::cvt_pk_bf16(lo, hi); }
template <typename TIn> struct Stage;
template <> struct Stage<bf16>  { using T = bf16x8;
  __device__ static __forceinline__ T ld8(const bf16* p) { return *reinterpret_cast<const bf16x8*>(p); }
  __device__ static __forceinline__ bf16x8 tobf(T x) { return x; } };
template <> struct Stage<float> { using T = f32x8;
  __device__ static __forceinline__ T ld8(const float* p) { return *reinterpret_cast<const f32x8*>(p); }
  __device__ static __forceinline__ bf16x8 tobf(T x) {
    u32x4 w = {cvtpk(x[0], x[1]), cvtpk(x[2], x[3]), cvtpk(x[4], x[5]), cvtpk(x[6], x[7])}; return *reinterpret_cast<bf16x8*>(&w); } };

__device__ __forceinline__ void partialSM(f32x16& p0, f32x16& p1, float& m_reg, float& mn, float& alpha) {
  constexpr float C = SCALE * 1.4426950408889634f;
  float pmax = p0[0]; for (int r = 1; r < 16; ++r) pmax = fmaxf(pmax, p0[r]); for (int r = 0; r < 16; ++r) pmax = fmaxf(pmax, p1[r]);
  { auto rr = __builtin_amdgcn_permlane32_swap(__float_as_uint(pmax), __float_as_uint(pmax), false, false);
    pmax = fmaxf(__uint_as_float(rr[0]), __uint_as_float(rr[1])); }
  if (__builtin_expect(__all(pmax - m_reg <= THR / SCALE), 1)) { mn = m_reg; alpha = 1.f; }
  else { mn = fmaxf(m_reg, pmax); alpha = __builtin_amdgcn_exp2f((m_reg - mn) * C); m_reg = mn; }
  float mnC = -mn * C;
  for (int r = 0; r < 16; ++r) p0[r] = fmaf(p0[r], C, mnC); for (int r = 0; r < 16; ++r) p1[r] = fmaf(p1[r], C, mnC);
  for (int r = 0; r < 16; ++r) p0[r] = __builtin_amdgcn_exp2f(p0[r]);
}
__device__ __forceinline__ void finishSM(f32x16& p0, f32x16& p1, float alpha, float& l_reg, bf16x8& pa0, bf16x8& pa1, bf16x8& pa2, bf16x8& pa3) {
  for (int r = 0; r < 16; ++r) p1[r] = __builtin_amdgcn_exp2f(p1[r]);
  float ps = 0; for (int r = 0; r < 16; ++r) ps += p0[r]; for (int r = 0; r < 16; ++r) ps += p1[r];
  { auto rr = __builtin_amdgcn_permlane32_swap(__float_as_uint(ps), __float_as_uint(ps), false, false);
    ps = __uint_as_float(rr[0]) + __uint_as_float(rr[1]); }
  l_reg = l_reg * alpha + ps;
#define PK4(P, BASE, OUT) do { unsigned a0 = cvtpk(P[BASE + 0], P[BASE + 1]), a1 = cvtpk(P[BASE + 2], P[BASE + 3]);   \
    unsigned b0 = cvtpk(P[BASE + 4], P[BASE + 5]), b1 = cvtpk(P[BASE + 6], P[BASE + 7]);                              \
    auto r0 = __builtin_amdgcn_permlane32_swap(a0, b0, false, false); auto r1 = __builtin_amdgcn_permlane32_swap(a1, b1, false, false); \
    u32x4 w = {r0[0], r1[0], r0[1], r1[1]}; OUT = *reinterpret_cast<bf16x8*>(&w); } while (0)
  PK4(p0, 0, pa0); PK4(p0, 8, pa1); PK4(p1, 0, pa2); PK4(p1, 8, pa3);
#undef PK4
}
__device__ __forceinline__ void qkt(f32x16& p0, f32x16& p1, const bf16* Ks, const bf16x8* qr, int r32, int hi) {
  p0 = f32x16{}; p1 = f32x16{};
  for (int d0 = 0; d0 < 8; ++d0) { int cb = (d0 * 16 + hi * 8) * 2;
    bf16x8 b0 = *reinterpret_cast<const bf16x8*>((const char*)Ks + KSWZ(r32, cb));
    bf16x8 b1 = *reinterpret_cast<const bf16x8*>((const char*)Ks + KSWZ(32 + r32, cb));
    p0 = __builtin_amdgcn_mfma_f32_32x32x16_bf16(b0, qr[d0], p0, 0, 0, 0);
    p1 = __builtin_amdgcn_mfma_f32_32x32x16_bf16(b1, qr[d0], p1, 0, 0, 0); }
}
__device__ __forceinline__ int v_st(int k, int c) { const int kk = (k & ~0xC) | ((k & 4) << 1) | ((k & 8) >> 1); return ((kk >> 3) * 4 + (c >> 5)) * 512 + ((kk & 7) * 32 + (c & 31)) * 2; }
__device__ __forceinline__ int v_rd_base(int lane) { return ((lane & 3) << 3) | (((lane >> 2) & 3) << 6) | (((lane >> 4) & 1) << 5) | (((lane >> 5) & 1) << 8); }
constexpr int v_rd_off(int d0, int ks, int half) { return d0 * 512 + ks * 4096 + half * 2048; }
template <int OFF> __device__ __forceinline__ s16x4 tr_read(int vb) {
  s16x4 r; asm volatile("ds_read_b64_tr_b16 %0, %1 offset:%2" : "=&v"(r) : "v"(vb), "i"(OFF) : "memory"); return r;
}
template <int D0> __device__ __forceinline__ void pv_one(f32x16& od, int vb, bf16x8 pa0, bf16x8 pa1, bf16x8 pa2, bf16x8 pa3) {
  const s16x4 l0 = tr_read<v_rd_off(D0, 0, 0)>(vb), h0 = tr_read<v_rd_off(D0, 0, 1)>(vb), l1 = tr_read<v_rd_off(D0, 1, 0)>(vb), h1 = tr_read<v_rd_off(D0, 1, 1)>(vb);
  const s16x4 l2 = tr_read<v_rd_off(D0, 2, 0)>(vb), h2 = tr_read<v_rd_off(D0, 2, 1)>(vb), l3 = tr_read<v_rd_off(D0, 3, 0)>(vb), h3 = tr_read<v_rd_off(D0, 3, 1)>(vb);
  asm volatile("s_waitcnt lgkmcnt(0)" ::: "memory"); SBAR();
#define PK(L, H) (bf16x8){L[0], L[1], L[2], L[3], H[0], H[1], H[2], H[3]}
  od = __builtin_amdgcn_mfma_f32_32x32x16_bf16(pa0, PK(l0, h0), od, 0, 0, 0);
  od = __builtin_amdgcn_mfma_f32_32x32x16_bf16(pa1, PK(l1, h1), od, 0, 0, 0);
  od = __builtin_amdgcn_mfma_f32_32x32x16_bf16(pa2, PK(l2, h2), od, 0, 0, 0);
  od = __builtin_amdgcn_mfma_f32_32x32x16_bf16(pa3, PK(l3, h3), od, 0, 0, 0);
#undef PK
}
__device__ __forceinline__ void pv_d0(f32x16* o, int vb, bf16x8 pa0, bf16x8 pa1, bf16x8 pa2, bf16x8 pa3) {
  pv_one<0>(o[0], vb, pa0, pa1, pa2, pa3); pv_one<1>(o[1], vb, pa0, pa1, pa2, pa3); pv_one<2>(o[2], vb, pa0, pa1, pa2, pa3); pv_one<3>(o[3], vb, pa0, pa1, pa2, pa3);
}
__device__ __forceinline__ void attn_dense_body(const bf16* __restrict__ Qb, const bf16* __restrict__ Kh, const bf16* __restrict__ Vh,
                                                const unsigned short* __restrict__ Gb, unsigned short* __restrict__ Yb, int seq, char* lds, const int tid) {
  using TQ = bf16; using St = Stage<bf16>; using SQ = Stage<TQ>;
  const int wid = tid >> 6, lane = tid & 63, r32 = lane & 31, hi = lane >> 5;
  bf16* V_lds = (bf16*)lds; bf16* K_lds = (bf16*)(lds + 2 * SHM_V);
  float* ws = (float*)(lds + 2 * SHM_V + 2 * SHM_K) + wid * 64; float* li_l = ws; float* al_l = ws + 32;
  float m_reg = -1e30f, l_reg = 0; f32x16 o[4] = {}; bf16x8 qr[8];
  const TQ* Qw = Qb + (long)(wid * QBLK + r32) * LDQ + hi * 8;
#pragma unroll
  for (int d0 = 0; d0 < 8; ++d0) qr[d0] = SQ::tobf(SQ::ld8(Qw + d0 * 16));
  const int sr = tid >> 4, sc = (tid & 15) * 8, vst0 = v_st(sr, sc), vst1 = v_st(32 + sr, sc);
  const int vb0 = (int)(uintptr_t)V_lds + v_rd_base(lane);
  struct { typename St::T vs0, vs1, ks0, ks1; } sr_[SDEPTH];
#define SLOAD(i, k0) do { sr_[i].vs0 = St::ld8(&Vh[(long)((k0) + sr) * LDK + sc]); sr_[i].vs1 = St::ld8(&Vh[(long)((k0) + 32 + sr) * LDK + sc]); \
    sr_[i].ks0 = St::ld8(&Kh[(long)((k0) + sr) * LDK + sc]); sr_[i].ks1 = St::ld8(&Kh[(long)((k0) + 32 + sr) * LDK + sc]); } while (0)
#define SWRITE(b, i) do { *(bf16x8*)((char*)V_lds + (b) * SHM_V + vst0) = St::tobf(sr_[i].vs0);          \
    *(bf16x8*)((char*)V_lds + (b) * SHM_V + vst1) = St::tobf(sr_[i].vs1); int kc = sc * 2;               \
    *(bf16x8*)((char*)K_lds + (b) * SHM_K + KSWZ(sr, kc)) = St::tobf(sr_[i].ks0);                       \
    *(bf16x8*)((char*)K_lds + (b) * SHM_K + KSWZ(32 + sr, kc)) = St::tobf(sr_[i].ks1); } while (0)
#define SWAIT() do { if constexpr (SDEPTH == 2) asm volatile("s_waitcnt vmcnt(4)" ::: "memory"); else asm volatile("s_waitcnt vmcnt(0)" ::: "memory"); } while (0)
#define RESC(a) do { if (__any((a) < 1.f)) { if (hi == 0) al_l[r32] = (a); asm volatile("s_waitcnt lgkmcnt(0)" ::: "memory"); \
    for (int d = 0; d < 4; ++d) for (int r = 0; r < 16; ++r) o[d][r] *= al_l[crow(r, hi)]; } } while (0)
  f32x16 pA0, pA1, pB0, pB1; float mnA, mnB, alA, alB; bf16x8 pa0, pa1, pa2, pa3; const int NT = seq / KVBLK;
  constexpr int SE = 0, SO = SDEPTH - 1;
  SLOAD(SE, 0); asm volatile("s_waitcnt vmcnt(0)" ::: "memory"); SWRITE(0, SE); __syncthreads();
  qkt(pA0, pA1, K_lds, qr, r32, hi); partialSM(pA0, pA1, m_reg, mnA, alA);
  SLOAD(SO, KVBLK); if constexpr (SDEPTH == 2) { if (2 < NT) SLOAD(SE, 2 * KVBLK); }
  SWAIT(); SWRITE(1, SO); __syncthreads();
  for (int j = 1; j + 1 < NT; j += 2) {
    SBAR(); qkt(pB0, pB1, (bf16*)((char*)K_lds + SHM_K), qr, r32, hi);
    finishSM(pA0, pA1, alA, l_reg, pa0, pa1, pa2, pa3); SBAR();
    SLOAD(SO, (j + SDEPTH) * KVBLK); SBAR();
    pv_d0(o, vb0, pa0, pa1, pa2, pa3); partialSM(pB0, pB1, m_reg, mnB, alB);
    __syncthreads(); SWAIT(); SWRITE(0, SE);
    RESC(alB); __syncthreads();
    SBAR(); qkt(pA0, pA1, K_lds, qr, r32, hi);
    finishSM(pB0, pB1, alB, l_reg, pa0, pa1, pa2, pa3); SBAR();
    if (SDEPTH == 1 || j + 3 < NT) SLOAD(SE, (j + 1 + SDEPTH) * KVBLK); SBAR();
    pv_d0(o, vb0 + (int)SHM_V, pa0, pa1, pa2, pa3); partialSM(pA0, pA1, m_reg, mnA, alA);
    __syncthreads(); SWAIT(); SWRITE(1, SO);
    RESC(alA); __syncthreads();
  }
  const unsigned short* Gw = Gb + (long)(wid * QBLK) * LDG;
  const int rsub = lane >> 4, c8 = (lane & 15) * 8;
  u32x4 gv[8];
#pragma unroll
  for (int it = 0; it < 8; ++it) gv[it] = *reinterpret_cast<const u32x4*>(Gw + (long)(it * 4 + rsub) * LDG + c8);
  SBAR(); qkt(pB0, pB1, (bf16*)((char*)K_lds + SHM_K), qr, r32, hi);
  finishSM(pA0, pA1, alA, l_reg, pa0, pa1, pa2, pa3); SBAR();
  pv_d0(o, vb0, pa0, pa1, pa2, pa3); partialSM(pB0, pB1, m_reg, mnB, alB);
  __syncthreads(); RESC(alB);
  finishSM(pB0, pB1, alB, l_reg, pa0, pa1, pa2, pa3); SBAR();
  pv_d0(o, vb0 + (int)SHM_V, pa0, pa1, pa2, pa3);
  if (hi == 0) li_l[r32] = l_reg; asm volatile("s_waitcnt lgkmcnt(0)" ::: "memory");
  float rli[16];
#pragma unroll
  for (int r = 0; r < 16; ++r) rli[r] = __builtin_amdgcn_rcpf(li_l[crow(r, hi)]);
  __syncthreads();
  { typedef __attribute__((address_space(3))) char lds_char; lds_char* ost = (lds_char*)lds + wid * 8192;
    const unsigned stb = (unsigned)(r32 * 2);
#pragma unroll
    for (int r = 0; r < 16; ++r) { const int orow = crow(r, hi);
#pragma unroll
      for (int d0 = 0; d0 < 4; ++d0) { const float v = o[d0][r] * rli[r]; unsigned u = __float_as_uint(v); u = (u + 0x7fffu + ((u >> 16) & 1u)) >> 16;
        *(__attribute__((address_space(3))) unsigned short*)(ost + orow * 256 + ((d0 * 64 + stb) ^ ((orow & 4) << 4))) = (unsigned short)u; } }
    asm volatile("s_waitcnt lgkmcnt(0)" ::: "memory");
    unsigned short* Yw = Yb + (long)(wid * QBLK) * LDY;
#pragma unroll
    for (int it = 0; it < 8; ++it) { const int row = it * 4 + rsub;
      const u32x4 ov = *(const __attribute__((address_space(3))) u32x4*)(ost + row * 256 + ((c8 * 2) ^ ((row & 4) << 4)));
      u32x4 w;
#pragma unroll
      for (int q = 0; q < 4; ++q) { const unsigned oo = ov[q], gg = gv[it][q];
        const float o_lo = __uint_as_float(oo << 16), o_hi = __uint_as_float(oo & 0xffff0000u), g_lo = __uint_as_float(gg << 16), g_hi = __uint_as_float(gg & 0xffff0000u);
        const float y_lo = o_lo * g_lo * __builtin_amdgcn_rcpf(1.0f + __expf(-g_lo)), y_hi = o_hi * g_hi * __builtin_amdgcn_rcpf(1.0f + __expf(-g_hi));
        w[q] = cvtpk(y_lo, y_hi); }
      *reinterpret_cast<u32x4*>(Yw + (long)row * LDY + c8) = w; } }
  __syncthreads();
#undef SLOAD
#undef SWRITE
#undef SWAIT
#undef RESC
}
}

constexpr int NWAVES = 8;
constexpr int RING_OFF = 0, RING_BYTES = 131072;
constexpr int LDSCTL_OFF = RING_BYTES, MISC_OFF = LDSCTL_OFF + 320;
constexpr int LDS_BYTES = 147456;

#define GAS __attribute__((address_space(1)))
#define LAS __attribute__((address_space(3)))
typedef unsigned short bf16;
typedef unsigned v4u __attribute__((ext_vector_type(4)));
typedef unsigned v2u __attribute__((ext_vector_type(2)));
typedef float f32x4 __attribute__((ext_vector_type(4)));
typedef short bf16x8 __attribute__((ext_vector_type(8)));
typedef GAS unsigned gu32;
#define RLX_AGENT __ATOMIC_RELAXED, __HIP_MEMORY_SCOPE_AGENT
#define LDS_WAIT() asm volatile("s_waitcnt lgkmcnt(0)" ::: "memory")
#define VM_WAIT() asm volatile("s_waitcnt vmcnt(0)" ::: "memory")
__device__ __forceinline__ unsigned f2bf(float f) { unsigned u = __builtin_bit_cast(unsigned, f); return (u + 0x7fffu + ((u >> 16) & 1u)) >> 16; }
__device__ __forceinline__ unsigned pk2(float lo, float hi) { return pg8::cvt_pk_bf16(lo, hi); }
__device__ __forceinline__ float bflo(unsigned w) { return __uint_as_float(w << 16); }
__device__ __forceinline__ float bfhi(unsigned w) { return __uint_as_float(w & 0xffff0000u); }
__device__ __forceinline__ float silu_f(float x) { return x * __builtin_amdgcn_rcpf(1.0f + __expf(-x)); }
__device__ __forceinline__ void unpack8(v4u w, float (&f)[8]) { f[0] = bflo(w.x); f[1] = bfhi(w.x); f[2] = bflo(w.y); f[3] = bfhi(w.y); f[4] = bflo(w.z); f[5] = bfhi(w.z); f[6] = bflo(w.w); f[7] = bfhi(w.w); }
__device__ __forceinline__ v4u pack8(const float (&f)[8]) { v4u w; w.x = pk2(f[0], f[1]); w.y = pk2(f[2], f[3]); w.z = pk2(f[4], f[5]); w.w = pk2(f[6], f[7]); return w; }
__device__ __forceinline__ float wave_sum(float v) {
#pragma unroll
    for (int o = 1; o < 64; o <<= 1) v += __shfl_xor(v, o);
    return v;
}

template <int CTRL> __device__ __forceinline__ float dpp_f(float v) { return __builtin_bit_cast(float, __builtin_amdgcn_update_dpp(0, __builtin_bit_cast(int, v), CTRL, 0xF, 0xF, true)); }
__device__ __forceinline__ float sum16(float v) {
    v += dpp_f<0xB1>(v); v += dpp_f<0x4E>(v); v += dpp_f<0x141>(v); v += dpp_f<0x140>(v); return v; }
__device__ __forceinline__ float lane_xor4(float v) {
    const int s = __builtin_bit_cast(int, v);
    int t = __builtin_amdgcn_update_dpp(0, s, 0x104, 0xF, 0x5, false);
    t = __builtin_amdgcn_update_dpp(t, s, 0x114, 0xF, 0xA, false);
    return __builtin_bit_cast(float, t); }

#define XB_TMO      128
#define XB_XCNT(j)  (256  + 64 * (j))
#define XB_XSUB(j)  (1280 + 64 * (j))
#define XB_XGEN(j)  (2304 + 64 * (j))
#define XB_TOP      3328
#define XB_TOPGEN   3392
#define XCD_BAR_WORDS 3456
#define XB_SPIN_CAP (1u << 18)

__device__ __forceinline__ unsigned xb_ld(unsigned* p)              { return __hip_atomic_load(p, __ATOMIC_RELAXED, __HIP_MEMORY_SCOPE_AGENT); }
__device__ __forceinline__ unsigned xb_add(unsigned* p, unsigned v) { return __hip_atomic_fetch_add(p, v, __ATOMIC_RELAXED, __HIP_MEMORY_SCOPE_AGENT); }
__device__ __forceinline__ unsigned xb_xcc_id() { return (unsigned)__builtin_amdgcn_s_getreg((3 << 11) | 20) & 0xFu; }
#define XB_SPIN(cond, bar) do { unsigned _sp = 0; while (cond) { __builtin_amdgcn_s_sleep(1); \
    if ((++_sp & 255u) == 0u) { if (xb_ld(&(bar)[XB_TMO])) break; if (_sp > XB_SPIN_CAP) { atomicAdd(&(bar)[XB_TMO], 1u); break; } } } } while (0)

struct XcdBarrier {
    unsigned* bar; unsigned x;
    volatile LAS unsigned* st;
};

__device__ __forceinline__ XcdBarrier xcd_barrier_post(unsigned* bar, volatile LAS unsigned* st) {
    XcdBarrier b; b.bar = bar; b.x = xb_xcc_id(); b.st = st;
    if (threadIdx.x == 0) (void)xb_add(&bar[XB_XCNT(b.x)], 1u);
    return b;
}
__device__ __forceinline__ void xcd_barrier_complete(unsigned* bar, unsigned x, unsigned& nloc, unsigned& nx) {
    const unsigned G = gridDim.x * gridDim.y * gridDim.z;
    unsigned sum, cnt, mine, sp = 0u;
    for (;;) {
        sum = 0u; cnt = 0u; mine = 0u;
#pragma unroll
        for (unsigned j = 0; j < 16; ++j) { const unsigned c = xb_ld(&bar[XB_XCNT(j)]); sum += c; cnt += (c > 0u) ? 1u : 0u; mine = (j == x) ? c : mine; }
        if (sum == G) break;
        __builtin_amdgcn_s_sleep(1);
        if ((++sp & 255u) == 0u) { if (xb_ld(&bar[XB_TMO])) break; if (sp > XB_SPIN_CAP) { atomicAdd(&bar[XB_TMO], 1u); break; } }
    }
    nloc = mine > 0u ? mine : 1u; nx = cnt > 0u ? cnt : 1u;
}

__device__ __forceinline__ void xcd_barrier(const XcdBarrier& b, const bool t0) {
    asm volatile("s_waitcnt vmcnt(0)" ::: "memory");
    __syncthreads();
    if (t0) {
        unsigned* bar = b.bar;
        __builtin_amdgcn_s_waitcnt(0);
        unsigned nloc = b.st[0], nx = b.st[1];
        if (nloc == 0u) { xcd_barrier_complete(bar, b.x, nloc, nx); b.st[0] = nloc; b.st[1] = nx; }
        const unsigned old = xb_add(&bar[XB_XSUB(b.x)], 1u);
        const unsigned gen = old / nloc;
        if (old + 1u == (gen + 1u) * nloc) {
            __builtin_amdgcn_fence(__ATOMIC_RELEASE, "agent");
            asm volatile("s_waitcnt vmcnt(0)" ::: "memory");
            const unsigned og = xb_add(&bar[XB_TOP], 1u);
            const unsigned tg = og / nx;
            if (og + 1u == (tg + 1u) * nx) xb_add(&bar[XB_TOPGEN], 1u);
            else XB_SPIN(xb_ld(&bar[XB_TOPGEN]) == tg, bar);
            __builtin_amdgcn_fence(__ATOMIC_ACQUIRE, "agent");
            xb_add(&bar[XB_XGEN(b.x)], 1u);
            asm volatile("s_waitcnt vmcnt(0)" ::: "memory");
        } else {
            XB_SPIN(xb_ld(&bar[XB_XGEN(b.x)]) == gen, bar);
            __builtin_amdgcn_fence(__ATOMIC_ACQUIRE, "agent");
            asm volatile("s_waitcnt vmcnt(0)" ::: "memory");
        }
    }
    __syncthreads();
}

__device__ __forceinline__ void p0_transpose_item(const float* W, int K, int N, bf16* WT, int item, int lane, float* cmax = nullptr, int cmode = 1, int ldw = 0, int koff = 0) {
    const int nblk = N / 64, kbk = item / nblk, nb = item % nblk, k0 = 64 * kbk + 8 * (lane >> 3), n0 = 64 * nb + 4 * (lane & 7);
    f32x4 v[2][8];
#pragma unroll
    for (int h = 0; h < 2; ++h)
#pragma unroll
        for (int e = 0; e < 8; ++e) v[h][e] = __builtin_nontemporal_load((const f32x4*)(W + (size_t)(k0 + e) * N + n0 + 32 * h));
#pragma unroll
    for (int h = 0; h < 2; ++h)
#pragma unroll
        for (int j = 0; j < 4; ++j) { v4u o; o.x = pk2(v[h][0][j], v[h][1][j]); o.y = pk2(v[h][2][j], v[h][3][j]); o.z = pk2(v[h][4][j], v[h][5][j]); o.w = pk2(v[h][6][j], v[h][7][j]);
            *(v4u*)(WT + (size_t)(n0 + 32 * h + j) * (ldw ? ldw : K) + koff + k0) = o; }
    if (cmax && (cmode == 2 || n0 < C_BF0 || n0 >= C_BF1)) { const int q0 = (cmode == 2 || n0 < C_BF0) ? n0 : n0 - (C_BF1 - C_BF0); const int cpitch = cmode == 2 ? DM : NI8;
#pragma unroll
        for (int h = 0; h < 2; ++h) { f32x4 mx4;
#pragma unroll
            for (int j = 0; j < 4; ++j) { float mx = 0.f;
#pragma unroll
                for (int e = 0; e < 8; ++e) mx = fmaxf(mx, fabsf(v[h][e][j]));
                mx = fmaxf(mx, __shfl_xor(mx, 8)); mx = fmaxf(mx, __shfl_xor(mx, 16)); mx = fmaxf(mx, __shfl_xor(mx, 32)); mx4[j] = mx; }
            if (lane < 8) *(f32x4*)(cmax + (size_t)kbk * cpitch + q0 + 32 * h) = mx4; }
    }
}
__device__ __forceinline__ void sincos_d(double a, float& c, float& s) {
    const double k = __builtin_rint(a * 0.15915494309189535);
    double r = __builtin_fma(-k, 6.283185307179586, a); r = __builtin_fma(-k, 2.4492935982947064e-16, r);
    const double r2 = r * r;
    double q = -r2;
    double sn = 3.8681701706306835e-23;
    sn = sn * q + 1.9572941063391263e-20; sn = sn * q + 8.22063524662433e-18; sn = sn * q + 2.8114572543455206e-15; sn = sn * q + 7.647163731819816e-13;
    sn = sn * q + 1.6059043836821613e-10; sn = sn * q + 2.505210838544172e-08; sn = sn * q + 2.7557319223985893e-06; sn = sn * q + 0.0001984126984126984;
    sn = sn * q + 0.008333333333333333; sn = sn * q + 0.16666666666666666; sn = sn * q + 1.0; sn = sn * r;
    double cs = 1.6117375710961184e-24;
    cs = cs * q + 8.896791392450574e-22; cs = cs * q + 4.110317623312165e-19; cs = cs * q + 1.5619206968586225e-16; cs = cs * q + 4.779477332387385e-14;
    cs = cs * q + 1.1470745597729725e-11; cs = cs * q + 2.08767569878681e-09; cs = cs * q + 2.755731922398589e-07; cs = cs * q + 2.48015873015873e-05;
    cs = cs * q + 0.001388888888888889; cs = cs * q + 0.041666666666666664; cs = cs * q + 0.5; cs = cs * q + 1.0;
    c = (float)cs; s = (float)sn;
}
__device__ __forceinline__ v4u norm_rope8(v4u in, const float* gain8, bool rope, int hl, int pos0, int pos1, const float* cosT, const float* sinT) {
    float f[8]; unpack8(in, f);
    float ss = 0.f;
#pragma unroll
    for (int e = 0; e < 8; ++e) ss += f[e] * f[e];
    ss += __shfl_xor(ss, 1); ss += __shfl_xor(ss, 2); ss += __shfl_xor(ss, 4); ss += __shfl_xor(ss, 8);
    const float rstd = 1.0f / sqrtf(ss * (1.0f / 128.0f) + EPS);
    const f32x4 g0 = *(const f32x4*)gain8, g1 = *(const f32x4*)(gain8 + 4);
    float y[8];
#pragma unroll
    for (int e = 0; e < 4; ++e) { y[e] = f[e] * rstd * g0[e]; y[4 + e] = f[4 + e] * rstd * g1[e]; }
    if (rope) {
        const int pos = (hl >> 3) ? pos1 : pos0, j0 = (hl & 3) * 8; const bool first = (hl & 7) < 4;
        const f32x4 c0 = *(const f32x4*)(cosT + pos * 32 + j0), c1 = *(const f32x4*)(cosT + pos * 32 + j0 + 4);
        const f32x4 s0 = *(const f32x4*)(sinT + pos * 32 + j0), s1 = *(const f32x4*)(sinT + pos * 32 + j0 + 4);
#pragma unroll
        for (int e = 0; e < 8; ++e) { const float py = __shfl_xor(y[e], 4); const float cs = e < 4 ? c0[e & 3] : c1[e & 3], sn = e < 4 ? s0[e & 3] : s1[e & 3];
            y[e] = first ? (y[e] * cs - py * sn) : (y[e] * cs + py * sn); }
    }
    return pack8(y);
}

struct Args { const float* in[20]; float* out; unsigned char* ws; };
typedef const Args __attribute__((address_space(4))) * ArgsP;
struct Ctx { int tid, lane, wave, gw, NGW, G, bx, vcu; ArgsP ap; unsigned char* ws; };
__device__ __forceinline__ int lane_id_fresh() { int ln; asm volatile("v_mbcnt_lo_u32_b32 %0, -1, 0\n\tv_mbcnt_hi_u32_b32 %0, -1, %0" : "=v"(ln)); return ln; }
__device__ __forceinline__ Ctx fresh_ctx(int wv) {
    Ctx c; int t = wv * 64 + lane_id_fresh(); c.tid = t; c.lane = t & 63; c.wave = wv;
    int G = gridDim.x, bx = blockIdx.x; asm volatile("" : "+s"(G), "+s"(bx));
    c.G = G; c.bx = bx; c.vcu = (G % 8 == 0) ? (bx % 8) * (G / 8) + bx / 8 : bx;
    c.gw = c.vcu * NWAVES + c.wave; c.NGW = G * NWAVES;
    ArgsP ap = (ArgsP)__builtin_amdgcn_kernarg_segment_ptr(); asm volatile("" : "+s"(ap)); c.ap = ap; c.ws = ap->ws;
    return c;
}

__device__ __forceinline__ void weight_transposes(const Ctx& c, int l, int it0, int it1, int w, int nw) {
    unsigned char* ws = c.ws; const int lane = c.lane;
    const float* w_in = c.ap->in[6]; const float* w_br_attn = c.ap->in[14]; const float* w_br_conv = c.ap->in[15]; const float* w_br_gm = c.ap->in[16]; const float* w_out = c.ap->in[17];
    for (int it = it0 + w; it < it1; it += nw) {
        int r = it;
        if (r < 24576) { p0_transpose_item(w_in + (size_t)l * DM * INC, DM, INC, (bf16*)(ws + WS_WIN + l * WIN_L), r, lane, (float*)(ws + WS_PMAX) + (size_t)l * 64 * NI8); continue; } r -= 24576;
        if (r < 2048) { p0_transpose_item(w_br_attn + (size_t)l * ATTN_W * DM, ATTN_W, DM, (bf16*)(ws + WS_WBR + l * WBR_L), r, lane, nullptr, 1, DM, 0); continue; } r -= 2048;
        if (r < 1024) { p0_transpose_item(w_br_conv + (size_t)l * CONV_W * DM, CONV_W, DM, (bf16*)(ws + WS_WBR + l * WBR_L), r, lane, nullptr, 1, DM, ATTN_W); continue; } r -= 1024;
        if (r < 1024) { p0_transpose_item(w_br_gm + (size_t)l * GM_W * DM, GM_W, DM, (bf16*)(ws + WS_WBR + l * WBR_L), r, lane, nullptr, 1, DM, ATTN_W + CONV_W); continue; } r -= 1024;
        p0_transpose_item(w_out + (size_t)l * DM * DM, DM, DM, (bf16*)(ws + WS_WOUT + l * WOUT_L), r, lane, (float*)(ws + WS_PMAXO) + (size_t)l * 64 * DM, 2);
    }
}
__device__ __forceinline__ float wave_max(float v) {
    v = fmaxf(v, dpp_f<0xB1>(v)); v = fmaxf(v, dpp_f<0x4E>(v)); v = fmaxf(v, dpp_f<0x141>(v)); v = fmaxf(v, dpp_f<0x140>(v));
    const float a = __builtin_bit_cast(float, __builtin_amdgcn_readlane(__builtin_bit_cast(int, v), 0)), b = __builtin_bit_cast(float, __builtin_amdgcn_readlane(__builtin_bit_cast(int, v), 16));
    const float cc = __builtin_bit_cast(float, __builtin_amdgcn_readlane(__builtin_bit_cast(int, v), 32)), d = __builtin_bit_cast(float, __builtin_amdgcn_readlane(__builtin_bit_cast(int, v), 48));
    return fmaxf(fmaxf(a, b), fmaxf(cc, d)); }
struct QRow { const float* pm; float* swp; const bf16* src; unsigned char* dst; };
__device__ __forceinline__ QRow qrow(const Ctx& c, int l, int nn) {
    const bool wo = nn >= NI8; const int n = wo ? nn - NI8 : nn, col = wo ? n : (n < C_BF0 ? n : n + (C_BF1 - C_BF0));
    QRow r;
    r.pm = wo ? (const float*)(c.ws + WS_PMAXO) + ((size_t)l * 64 + c.lane) * DM + n : (const float*)(c.ws + WS_PMAX) + ((size_t)l * 64 + c.lane) * NI8 + n;
    r.swp = wo ? (float*)(c.ws + WS_SWO) + l * DM + n : (float*)(c.ws + WS_SW) + l * NI8 + n;
    r.src = (wo ? (const bf16*)(c.ws + WS_WOUT + l * WOUT_L) : (const bf16*)(c.ws + WS_WIN + l * WIN_L)) + (size_t)col * DM;
    r.dst = (wo ? c.ws + WS_W8O + l * W8O_L : c.ws + WS_W8 + l * W8_L) + (size_t)n * DM;
    return r; }
__device__ __forceinline__ void quantize_w8(const Ctx& c, int l, int nn0, int nn1) {
#pragma unroll 1
    for (int nnA = nn0 + c.gw; nnA < nn1; nnA += 2 * c.NGW) {
        const bool hasB = nnA + c.NGW < nn1;
        const QRow ra = qrow(c, l, nnA), rb = qrow(c, l, hasB ? nnA + c.NGW : nnA);
        float mxa = *ra.pm, mxb = *rb.pm;
        v4u ia[8], ib[8];
#pragma unroll
        for (int j = 0; j < 8; ++j) { ia[j] = *(const v4u*)(ra.src + j * 512 + c.lane * 8); ib[j] = *(const v4u*)(rb.src + j * 512 + c.lane * 8); }
        mxa = wave_max(mxa); mxb = wave_max(mxb);
        const float sca = mxa > 0.f ? mxa * (1.0f / 127.0f) : 1.0f, inva = 1.0f / sca, scb = mxb > 0.f ? mxb * (1.0f / 127.0f) : 1.0f, invb = 1.0f / scb;
        if (c.lane == 0) { __hip_atomic_store(ra.swp, sca, __ATOMIC_RELAXED, __HIP_MEMORY_SCOPE_AGENT);
            if (hasB) __hip_atomic_store(rb.swp, scb, __ATOMIC_RELAXED, __HIP_MEMORY_SCOPE_AGENT); }
#pragma unroll
        for (int h = 0; h < 2; ++h) { if (h == 1 && !hasB) break;
#pragma unroll
            for (int j = 0; j < 8; ++j) { float f[8]; unpack8(h ? ib[j] : ia[j], f); int q[8]; const float inv = h ? invb : inva;
#pragma unroll
                for (int e = 0; e < 8; ++e) q[e] = __float2int_rn(f[e] * inv);
                v2u w; w.x = (unsigned)(q[0] & 255) | ((unsigned)(q[1] & 255) << 8) | ((unsigned)(q[2] & 255) << 16) | ((unsigned)(q[3] & 255) << 24);
                w.y = (unsigned)(q[4] & 255) | ((unsigned)(q[5] & 255) << 8) | ((unsigned)(q[6] & 255) << 16) | ((unsigned)(q[7] & 255) << 24);
                *(v2u*)((h ? rb.dst : ra.dst) + j * 512 + c.lane * 8) = w; } }
    }
}
__device__ __forceinline__ void modp_items(const Ctx& c, int l, int w, int nw) {
    const float* c_in = c.ap->in[1]; const float* cctx_in = c.ap->in[3]; const float* w_ada = c.ap->in[4];
    float* modp = (float*)(c.ws + WS_MODP); const int lane = c.lane;
    for (int r = w; r < NKC * 48; r += nw) {
        const int kc = r / 48, cb = r % 48;
        const float* W = w_ada + ((size_t)l * DM + kc * 64) * 12288 + cb * 256 + lane * 4;
        f32x4 a0 = {0.f, 0.f, 0.f, 0.f}, a1 = a0, a2 = a0;
        const int cvi0 = __builtin_bit_cast(int, silu_f(c_in[kc * 64 + lane])), cvi1 = __builtin_bit_cast(int, silu_f(c_in[DM + kc * 64 + lane])), cvi2 = __builtin_bit_cast(int, silu_f(cctx_in[kc * 64 + lane]));
#pragma unroll 1
        for (int k0 = 0; k0 < 64; k0 += 16) { f32x4 wv[16];
#pragma unroll
            for (int j = 0; j < 16; ++j) wv[j] = __builtin_nontemporal_load((const f32x4*)(W + (size_t)(k0 + j) * 12288));
#pragma unroll
            for (int j = 0; j < 16; ++j) { const float s0 = __builtin_bit_cast(float, __builtin_amdgcn_readlane(cvi0, k0 + j)), s1 = __builtin_bit_cast(float, __builtin_amdgcn_readlane(cvi1, k0 + j)), s2 = __builtin_bit_cast(float, __builtin_amdgcn_readlane(cvi2, k0 + j));
                a0 += wv[j] * s0; a1 += wv[j] * s1; a2 += wv[j] * s2; } }
        float* o = modp + ((size_t)(l * NKC + kc) * 3) * 12288 + cb * 256 + lane * 4;
        *(f32x4*)o = a0; *(f32x4*)(o + 12288) = a1; *(f32x4*)(o + 2 * 12288) = a2;
    }
}
__device__ __forceinline__ void modv_reduce(const Ctx& c, int l) {
    const float* b_ada = c.ap->in[5]; float* modv = (float*)(c.ws + WS_MOD); const float* modp = (const float*)(c.ws + WS_MODP);
    for (int r = c.gw * 64 + c.lane; r < 3 * 12288; r += c.NGW * 64) { const int w = r / 12288, col = r % 12288;
        const float* mp = modp + ((size_t)(l * NKC) * 3 + w) * 12288 + col;
        float s = b_ada[l * 12288 + col];
#pragma unroll
        for (int h = 0; h < NKC / 32; ++h) { float v[32];
#pragma unroll
            for (int k = 0; k < 32; ++k) v[k] = mp[(size_t)(h * 32 + k) * 3 * 12288];
#pragma unroll
            for (int k = 0; k < 32; ++k) s += v[k]; }
        modv[l * 36864 + r] = s; }
}
__device__ __forceinline__ void direct_w8_block(const Ctx& c, LAS unsigned char* lds, const float* Wsrc, const int INC_, int srccol, unsigned char* dstrow, float* swdst) {
    const int lane = c.lane, wave = c.wave, kr = lane >> 3, nc = lane & 7;
    const float* W = Wsrc + (size_t)(512 * wave + 8 * kr) * INC_ + srccol + 4 * nc;
    LAS float* pm = (LAS float*)(lds + RING_BYTES + 2048);
    LAS unsigned char* hl = lds + RING_OFF + wave * 16384 + lane * 16;
    f32x4 mx = {0.f, 0.f, 0.f, 0.f};
    unsigned held[4][4][4];
#pragma unroll
    for (int t = 0; t < 8; ++t) { f32x4 v[8]; const float* Wt = W + (size_t)(t * 64) * INC_; asm volatile("" : "+v"(Wt));
#pragma unroll
        for (int e = 0; e < 8; ++e) v[e] = __builtin_nontemporal_load((const f32x4*)(Wt + (size_t)e * INC_));
#pragma unroll
        for (int j = 0; j < 4; ++j) {
#pragma unroll
            for (int e = 0; e < 8; ++e) mx[j] = fmaxf(mx[j], fabsf(v[e][j]));
            v4u pk; pk.x = pk2(v[0][j], v[1][j]); pk.y = pk2(v[2][j], v[3][j]); pk.z = pk2(v[4][j], v[5][j]); pk.w = pk2(v[6][j], v[7][j]);
            if (t < 4) { held[t & 3][j][0] = pk.x; held[t & 3][j][1] = pk.y; held[t & 3][j][2] = pk.z; held[t & 3][j][3] = pk.w; }
            else *(LAS v4u*)(hl + ((t - 4) * 4 + j) * 1024) = pk; }
        if (t & 1) { asm volatile("" ::: "memory"); __builtin_amdgcn_sched_barrier(0); } }
#pragma unroll
    for (int j = 0; j < 4; ++j) { float m = mx[j]; m = fmaxf(m, __shfl_xor(m, 8)); m = fmaxf(m, __shfl_xor(m, 16)); m = fmaxf(m, __shfl_xor(m, 32)); mx[j] = m; }
    if (kr == 0) *(LAS f32x4*)(pm + wave * 32 + 4 * nc) = mx;
    __syncthreads();
    f32x4 cm = *(const LAS f32x4*)(pm + 4 * nc);
#pragma unroll
    for (int w2 = 1; w2 < 8; ++w2) { const f32x4 o = *(const LAS f32x4*)(pm + w2 * 32 + 4 * nc);
#pragma unroll
        for (int j = 0; j < 4; ++j) cm[j] = fmaxf(cm[j], o[j]); }
    __syncthreads();
    f32x4 sc, inv;
#pragma unroll
    for (int j = 0; j < 4; ++j) { sc[j] = cm[j] > 0.f ? cm[j] * (1.0f / 127.0f) : 1.0f; inv[j] = 1.0f / sc[j]; }
    if (wave == 0 && kr == 0) *(f32x4*)(swdst + 4 * nc) = sc;
    unsigned char* dst = dstrow + (size_t)(4 * nc) * DM + 512 * wave + 8 * kr;
#pragma unroll
    for (int t = 0; t < 8; ++t) { unsigned char* dt = dst + t * 64; asm volatile("" : "+v"(dt));
#pragma unroll
        for (int j = 0; j < 4; ++j) { v4u pk;
            if (t < 4) { pk.x = held[t & 3][j][0]; pk.y = held[t & 3][j][1]; pk.z = held[t & 3][j][2]; pk.w = held[t & 3][j][3]; }
            else pk = *(const LAS v4u*)(hl + ((t - 4) * 4 + j) * 1024);
            int qi[8];
#pragma unroll
            for (int pr = 0; pr < 4; ++pr) { qi[2 * pr] = __float2int_rn(bflo(pk[pr]) * inv[j]); qi[2 * pr + 1] = __float2int_rn(bfhi(pk[pr]) * inv[j]); }
            v2u w; w.x = (unsigned)(qi[0] & 255) | ((unsigned)(qi[1] & 255) << 8) | ((unsigned)(qi[2] & 255) << 16) | ((unsigned)(qi[3] & 255) << 24);
            w.y = (unsigned)(qi[4] & 255) | ((unsigned)(qi[5] & 255) << 8) | ((unsigned)(qi[6] & 255) << 16) | ((unsigned)(qi[7] & 255) << 24);
            *(v2u*)(dt + (size_t)j * DM) = w; } }
}
__device__ __forceinline__ void direct_win_block(const Ctx& c, LAS unsigned char* lds, int l, int cb) {
    const int n8 = 32 * cb; direct_w8_block(c, lds, c.ap->in[6] + (size_t)l * DM * INC, INC, n8 < C_BF0 ? n8 : n8 + (C_BF1 - C_BF0), c.ws + WS_W8 + l * W8_L + (size_t)n8 * DM, (float*)(c.ws + WS_SW) + l * NI8 + n8); }
__device__ __forceinline__ void direct_wout_block(const Ctx& c, LAS unsigned char* lds, int l, int cb) {
    const int n8 = 32 * cb; direct_w8_block(c, lds, c.ap->in[17] + (size_t)l * DM * DM, DM, n8, c.ws + WS_W8O + l * W8O_L + (size_t)n8 * DM, (float*)(c.ws + WS_SWO) + l * DM + n8); }
__device__ __forceinline__ void bf16_tiles(const Ctx& c, int l, int j0, int j1, int w, int nw) {
    unsigned char* ws = c.ws; const int lane = c.lane; constexpr int NBT = (C_BF1 - C_BF0) / 64;
#pragma unroll 1
    for (int j = j0 + w; j < j1; j += nw) {
        if (j < 64 * NBT) { p0_transpose_item(c.ap->in[6] + (size_t)l * DM * INC, DM, INC, (bf16*)(ws + WS_WIN + l * WIN_L), (j / NBT) * (INC / 64) + C_BF0 / 64 + j % NBT, lane, nullptr); continue; }
        int r = j - 64 * NBT;
        if (r < 2048) { p0_transpose_item(c.ap->in[14] + (size_t)l * ATTN_W * DM, ATTN_W, DM, (bf16*)(ws + WS_WBR + l * WBR_L), r, lane, nullptr, 1, DM, 0); continue; } r -= 2048;
        if (r < 1024) { p0_transpose_item(c.ap->in[15] + (size_t)l * CONV_W * DM, CONV_W, DM, (bf16*)(ws + WS_WBR + l * WBR_L), r, lane, nullptr, 1, DM, ATTN_W); continue; } r -= 1024;
        p0_transpose_item(c.ap->in[16] + (size_t)l * GM_W * DM, GM_W, DM, (bf16*)(ws + WS_WBR + l * WBR_L), r, lane, nullptr, 1, DM, ATTN_W + CONV_W);
    }
}
__device__ __forceinline__ void phase_tail_transposes(LAS unsigned char* lds, int part, int wv) {
    const Ctx c = fresh_ctx(wv);
    constexpr int NB1 = NI8 / 32, NBO = DM / 32, NT0 = 128;
    if (part == 0) {
        if (c.G != 256) { bf16_tiles(c, 0, 7168, 11264, c.gw, c.NGW); for (int cb = c.vcu; cb < NT0; cb += c.G) direct_win_block(c, lds, 1, cb); return; }
        if (c.vcu < 192) return;
        bf16_tiles(c, 0, 7168, 11264, (c.vcu - 192) * NWAVES + c.wave, 64 * NWAVES);
        for (int cb = c.vcu - 192; cb < NT0; cb += 64) direct_win_block(c, lds, 1, cb);
        return; }
    const int nbusy = (34 * 16) % c.G;
    if (c.vcu < nbusy) return;
    const int idx = c.vcu - nbusy, nidle = c.G - nbusy, w = idx * NWAVES + c.wave, nw = nidle * NWAVES;
    if (part == 1) {
        for (int cb = idx; cb < NBO; cb += nidle) direct_wout_block(c, lds, 0, cb);
        modp_items(c, 1, w, nw);
        const int rot = nidle > NBO ? nidle - NBO : 0;
        for (int k = (idx + rot) % nidle; k < NB1 - NT0; k += nidle) direct_win_block(c, lds, 1, NT0 + k); }
    else {
        for (int cb = idx; cb < NBO; cb += nidle) direct_wout_block(c, lds, 1, cb);
        bf16_tiles(c, 1, 0, 11264, w, nw); }
}
__device__ __forceinline__ void phase_p0(LAS unsigned char* lds, int wv) {
    const Ctx c = fresh_ctx(wv); unsigned char* ws = c.ws; const int lane = c.lane;
    constexpr int NBLK = NI8 / 32;
    for (int cb = c.vcu; cb < NBLK; cb += c.G) direct_win_block(c, lds, 0, cb);
    const int nx = (NBLK > 2 * c.G && NBLK < 3 * c.G) ? NBLK - 2 * c.G : 0;
    if (c.vcu >= nx) { const int w = (c.vcu - nx) * NWAVES + c.wave, nw = (c.G - nx) * NWAVES;
        bf16_tiles(c, 0, 0, 64 * ((C_BF1 - C_BF0) / 64), w, nw);
        modp_items(c, 0, w, nw); }
    float* cosT = (float*)(ws + WS_ROPE); float* sinT = cosT + 2048;
    for (int i = c.gw * 64 + lane; i < 2048; i += c.NGW * 64) { const int pos = i >> 5, j = i & 31;
        double f = 1.0; for (int q = 0; q < j; ++q) f *= 0.7498942093324558273;
        float cs, sn; sincos_d((double)pos * f, cs, sn); cosT[i] = cs; sinT[i] = sn; }
}
__device__ __forceinline__ void phase_p1(int wv) {
    const Ctx c = fresh_ctx(wv);
    modv_reduce(c, 0);
}
__device__ __forceinline__ void store_u_row(const f32x4 (&u)[16], int row, int lane, bf16* Ub, unsigned char* U8, float* su) {
    float mx = 0.f;
#pragma unroll
    for (int j = 0; j < 16; ++j) { mx = fmaxf(mx, fmaxf(fmaxf(fabsf(u[j][0]), fabsf(u[j][1])), fmaxf(fabsf(u[j][2]), fabsf(u[j][3]))));
        v2u w; w.x = pk2(u[j][0], u[j][1]); w.y = pk2(u[j][2], u[j][3]); *(v2u*)(Ub + (size_t)row * DM + lane * 4 + 256 * j) = w; }
#pragma unroll
    for (int o = 1; o < 64; o <<= 1) mx = fmaxf(mx, __shfl_xor(mx, o));
    const float sc = mx > 0.f ? mx * (1.0f / 127.0f) : 1.0f, inv = 1.0f / sc;
    if (lane == 0) __hip_atomic_store(su + row, sc, __ATOMIC_RELAXED, __HIP_MEMORY_SCOPE_AGENT);
#pragma unroll
    for (int j = 0; j < 16; ++j) { const int q0 = __float2int_rn(u[j][0] * inv), q1 = __float2int_rn(u[j][1] * inv), q2 = __float2int_rn(u[j][2] * inv), q3 = __float2int_rn(u[j][3] * inv);
        *(unsigned*)(U8 + (size_t)row * DM + lane * 4 + 256 * j) = (unsigned)(q0 & 255) | ((unsigned)(q1 & 255) << 8) | ((unsigned)(q2 & 255) << 16) | ((unsigned)(q3 & 255) << 24); }
}
__device__ __forceinline__ void phase_p2(int wv) {
    const Ctx c = fresh_ctx(wv); const float* x_in = c.ap->in[0]; const float* ctx_in = c.ap->in[2];
    const float* modv = (const float*)(c.ws + WS_MOD); bf16* Ub = (bf16*)(c.ws + WS_U); const int lane = c.lane;
#pragma unroll 2
    for (int row = c.gw; row < MT; row += c.NGW) {
        const float* src = row < NLAT ? x_in + (size_t)row * DM : ctx_in + (size_t)(row - NLAT) * DM;
        const float* mr = modv + (row < SEQ ? 0 : (row < NLAT ? 1 : 2)) * 12288;
        f32x4 u[16];
#pragma unroll
        for (int j = 0; j < 16; ++j) { const int col = lane * 4 + 256 * j;
            const f32x4 xv = *(const f32x4*)(src + col), sh = *(const f32x4*)(mr + col), sc = *(const f32x4*)(mr + DM + col);
            u[j] = xv * (sc + 1.0f) + sh; }
        store_u_row(u, row, lane, Ub, c.ws + WS_U8, (float*)(c.ws + WS_SU));
    }
}
__device__ __forceinline__ void phase_g1a(LAS unsigned char* lds, int l, int wv) {
    const Ctx c = fresh_ctx(wv); const bool last = (l == DEPTH - 1);
    pg8::Gemm g{(const bf16*)(c.ws + WS_U), (const bf16*)(c.ws + WS_WIN + l * WIN_L) + (size_t)C_BF0 * DM, DM, DM, DM};
    pg8::Order S; S.init(last ? 32 : 34, (C_BF1 - C_BF0) / 256, c.G, c.vcu, 0); S.noremap = 1;
    if (last && c.G == 256) { S.seg = 1; S.sn0 = 2; S.sw0 = 256; S.sn1 = 1; S.sw1 = 248; S.sn2 = 1; S.sw2 = 136; }
    pg8::EpiBf16 E{(bf16*)(c.ws + WS_P) + C_BF0, INC, 1 << 30};
    pg8::gemm_phase<pg8::EpiBf16, pg8::Order, true, true, false>(lds + RING_OFF, g, S, E, c.tid);
}
__device__ __forceinline__ void phase_g1b(LAS unsigned char* lds, int l, int wv) {
    const Ctx c = fresh_ctx(wv); const bool last = (l == DEPTH - 1);
    pg8::Gemm g{(const bf16*)(c.ws + WS_U8), (const bf16*)(c.ws + WS_W8 + l * W8_L), DM / 2, DM / 2, DM / 2};
    const int nA = (last ? 32 : 34) * ((C_BF1 - C_BF0) / 256), nlong = nA % c.G, n3 = nlong ? c.G - nlong : c.G;
    pg8::Order S; S.init(last ? 32 : 34, NI8 / 256, c.G, (c.vcu + n3) % c.G, last ? 8 : 0, n3); S.noremap = 1;
    if (last && c.G == 256) { S.c = c.G - 1 - c.vcu; S.seg = 1; S.sn0 = 8; S.sw0 = 256; S.sn1 = 1; S.sw1 = 120; S.sn2 = 2; S.sw2 = 8; }
    pg8::EpiGateI8 E{(bf16*)(c.ws + WS_P), INC, (const float*)(c.ws + WS_SU), (const float*)(c.ws + WS_SW) + l * NI8};
    pg8::gemm_phase<pg8::EpiGateI8, pg8::Order, true, true, true>(lds + RING_OFF, g, S, E, c.tid);
}
__device__ __forceinline__ v4u norm_rope8b(v4u in, const f32x4 g0, const f32x4 g1, bool rope, bool first, const f32x4 c0, const f32x4 c1, const f32x4 s0, const f32x4 s1) {
    float f[8]; unpack8(in, f);
    float ss = 0.f;
#pragma unroll
    for (int e = 0; e < 8; ++e) ss += f[e] * f[e];
    ss = sum16(ss);
    const float rstd = 1.0f / sqrtf(ss * (1.0f / 128.0f) + EPS);
    float y[8];
#pragma unroll
    for (int e = 0; e < 4; ++e) { y[e] = f[e] * rstd * g0[e]; y[4 + e] = f[4 + e] * rstd * g1[e]; }
    if (rope) {
#pragma unroll
        for (int e = 0; e < 8; ++e) { const float py = lane_xor4(y[e]); const float cs = e < 4 ? c0[e & 3] : c1[e & 3], sn = e < 4 ? s0[e & 3] : s1[e & 3];
            y[e] = first ? (y[e] * cs - py * sn) : (y[e] * cs + py * sn); }
    }
    return pack8(y);
}
__device__ __forceinline__ void phase_t1_rows(int l, int wv) {
    const Ctx c = fresh_ctx(wv); const bool last = (l == DEPTH - 1); const int lane = c.lane;
    const float* qn = c.ap->in[7] + l * HD; const float* kn = c.ap->in[8] + l * HD; const float* cw = c.ap->in[9] + l * 3 * CONV_W;
    const float* cosT = (const float*)(c.ws + WS_ROPE); const float* sinT = cosT + 2048;
    const bf16* Pb = (const bf16*)(c.ws + WS_P); bf16* Qb = (bf16*)(c.ws + WS_Q); bf16* Kb = (bf16*)(c.ws + WS_K); bf16* Vb = (bf16*)(c.ws + WS_V); bf16* Yb = (bf16*)(c.ws + WS_Y);
    const int hl = lane & 15, j0 = (hl & 3) * 8; const bool first = (hl & 7) < 4;
    const f32x4 qg0 = *(const f32x4*)(qn + hl * 8), qg1 = *(const f32x4*)(qn + hl * 8 + 4), kg0 = *(const f32x4*)(kn + hl * 8), kg1 = *(const f32x4*)(kn + hl * 8 + 4);
    const int ngm = (last ? NLAT : MT) / 128 * 4, nx = (ngm > c.G && ngm < 2 * c.G) ? ngm - c.G : 0;
    if (c.vcu < nx) return;
    const int gw0 = (c.vcu - nx) * NWAVES + c.wave, ngw = (c.G - nx) * NWAVES;
#pragma unroll 1
    for (int row = gw0; row < MT; row += ngw) {
        const bool isctx = row >= NLAT;
        const int b = isctx ? ((row - NLAT) >> 8) : (row >> 12), t = isctx ? ((row - NLAT) & 255) : (row & 4095);
        const bf16* Prow = Pb + (size_t)row * INC;
        const size_t krow = (size_t)b * SKV + (isctx ? t : CTXL + t);
        const int pos = (hl >> 3) ? (t & 63) : (t >> 6);
        const f32x4 c0 = *(const f32x4*)(cosT + pos * 32 + j0), c1 = *(const f32x4*)(cosT + pos * 32 + j0 + 4);
        const f32x4 s0 = *(const f32x4*)(sinT + pos * 32 + j0), s1 = *(const f32x4*)(sinT + pos * 32 + j0 + 4);
        const v4u kin = *(const v4u*)(Prow + C_K + lane * 8), vin = *(const v4u*)(Prow + C_V + lane * 8);
        if (isctx && last) {
            *(v4u*)(Kb + krow * KV_W + lane * 8) = norm_rope8b(kin, kg0, kg1, false, first, c0, c1, s0, s1);
            *(v4u*)(Vb + krow * KV_W + lane * 8) = vin;
            continue;
        }
        v4u qin[4];
#pragma unroll
        for (int ch = 0; ch < 4; ++ch) qin[ch] = *(const v4u*)(Prow + C_Q + ch * 512 + lane * 8);
        const int seqlen = isctx ? CTXL : SEQ;
        const bool hasm = t > 0, hasp = t < seqlen - 1;
        const bf16* Pm = hasm ? Prow - INC : Prow; const bf16* Pp = hasp ? Prow + INC : Prow;
        const float m0 = hasm ? 1.f : 0.f, m2 = hasp ? 1.f : 0.f;
        v4u am[2], bm[2], a0[2], b0[2], ap[2], bp[2], cbw[2], cgw[2]; f32x4 w[2][6];
#pragma unroll
        for (int ch = 0; ch < 2; ++ch) { const int cc = ch * 512 + lane * 8;
            am[ch] = *(const v4u*)(Pm + C_CC + cc); bm[ch] = *(const v4u*)(Pm + C_CH + cc);
            a0[ch] = *(const v4u*)(Prow + C_CC + cc); b0[ch] = *(const v4u*)(Prow + C_CH + cc);
            ap[ch] = *(const v4u*)(Pp + C_CC + cc); bp[ch] = *(const v4u*)(Pp + C_CH + cc);
            cbw[ch] = *(const v4u*)(Prow + C_CB + cc); cgw[ch] = *(const v4u*)(Prow + C_CG + cc);
#pragma unroll
            for (int tp = 0; tp < 3; ++tp) { w[ch][2 * tp] = *(const f32x4*)(cw + tp * CONV_W + cc); w[ch][2 * tp + 1] = *(const f32x4*)(cw + tp * CONV_W + cc + 4); } }
#pragma unroll
        for (int ch = 0; ch < 4; ++ch) *(v4u*)(Qb + (size_t)row * ATTN_W + ch * 512 + lane * 8) = norm_rope8b(qin[ch], qg0, qg1, !isctx, first, c0, c1, s0, s1);
        *(v4u*)(Kb + krow * KV_W + lane * 8) = norm_rope8b(kin, kg0, kg1, !isctx, first, c0, c1, s0, s1);
        *(v4u*)(Vb + krow * KV_W + lane * 8) = vin;
#pragma unroll
        for (int ch = 0; ch < 2; ++ch) { const int cc = ch * 512 + lane * 8;
            float fa[8], fb[8], z0[8], z1[8], z2[8], cbv[8], cgv[8], y[8];
            unpack8(am[ch], fa); unpack8(bm[ch], fb);
#pragma unroll
            for (int e = 0; e < 8; ++e) z0[e] = fa[e] * fb[e] * m0;
            unpack8(a0[ch], fa); unpack8(b0[ch], fb);
#pragma unroll
            for (int e = 0; e < 8; ++e) z1[e] = fa[e] * fb[e];
            unpack8(ap[ch], fa); unpack8(bp[ch], fb);
#pragma unroll
            for (int e = 0; e < 8; ++e) z2[e] = fa[e] * fb[e] * m2;
            unpack8(cbw[ch], cbv); unpack8(cgw[ch], cgv);
#pragma unroll
            for (int e = 0; e < 8; ++e) { const float w0 = w[ch][e >> 2][e & 3], w1 = w[ch][2 + (e >> 2)][e & 3], w2 = w[ch][4 + (e >> 2)][e & 3];
                y[e] = cbv[e] * (w0 * z0[e] + w1 * z1[e] + w2 * z2[e]) * silu_f(cgv[e]); }
            *(v4u*)(Yb + (size_t)row * DM + ATTN_W + cc) = pack8(y); }
    }
}
struct GmOps { f32x4 wr[8]; v4u uw[4], gw[4], vs[4]; f32x4 ga0, ga1, be0, be1; float bias; };
struct GmCtx { int l, r0, wave, fr, fq; const bf16* Pb; bf16* Yb; const float* lng; const float* lnb; const float* gm_ws; const float* gm_b; };
__device__ __forceinline__ void gm_load(GmOps& o, const GmCtx& G, int g) {
    const float* Wsp = G.gm_ws + ((size_t)(G.l * 8 + g) * 128 + G.wave * 16 + G.fr) * 128 + G.fq * 8;
#pragma unroll
    for (int kk = 0; kk < 4; ++kk) { o.wr[2 * kk] = *(const f32x4*)(Wsp + kk * 32); o.wr[2 * kk + 1] = *(const f32x4*)(Wsp + kk * 32 + 4); }
    const size_t orow = (size_t)(G.r0 + G.wave * 16 + G.fr);
#pragma unroll
    for (int j = 0; j < 4; ++j) { const int d = g * 128 + 32 * G.fq + 8 * j; o.uw[j] = *(const v4u*)(G.Pb + orow * INC + C_GU + d); o.gw[j] = *(const v4u*)(G.Pb + orow * INC + C_GG + d); }
    o.bias = G.gm_b[(G.l * 8 + g) * 128 + G.wave * 16 + G.fr];
    const int gc = g * 128 + G.fr * 8;
    o.ga0 = *(const f32x4*)(G.lng + gc); o.ga1 = *(const f32x4*)(G.lng + gc + 4); o.be0 = *(const f32x4*)(G.lnb + gc); o.be1 = *(const f32x4*)(G.lnb + gc + 4);
#pragma unroll
    for (int bt = 0; bt < 4; ++bt) o.vs[bt] = *(const v4u*)(G.Pb + (size_t)(G.r0 + G.wave * 16 + bt * 4 + G.fq) * INC + C_GV + gc);
}
__device__ __forceinline__ void gm_norm(const GmOps& o, const GmCtx& G, const float (&mean)[4], const float (&rstd)[4], LAS bf16* vnT) {
#pragma unroll
    for (int bt = 0; bt < 4; ++bt) { const int rr = G.wave * 16 + bt * 4 + G.fq; float f[8]; unpack8(o.vs[bt], f);
#pragma unroll
        for (int e = 0; e < 8; ++e) { const float gg = e < 4 ? o.ga0[e & 3] : o.ga1[e & 3], bb = e < 4 ? o.be0[e & 3] : o.be1[e & 3];
            vnT[(e * 16 + G.fr) * 136 + rr] = (bf16)f2bf((f[e] - mean[bt]) * rstd[bt] * gg + bb); } }
}
__device__ __forceinline__ void gm_mma_epi(const GmOps& o, const GmCtx& G, int g, const LAS bf16* vnT) {
    const int fr = G.fr, fq = G.fq;
    f32x4 acc[8];
#pragma unroll
    for (int nb = 0; nb < 8; ++nb) acc[nb] = (f32x4){0.f, 0.f, 0.f, 0.f};
#pragma unroll
    for (int kk = 0; kk < 4; ++kk) {
        const f32x4 wa = o.wr[2 * kk], wb = o.wr[2 * kk + 1];
        v4u aw; aw.x = pk2(wa[0], wa[1]); aw.y = pk2(wa[2], wa[3]); aw.z = pk2(wb[0], wb[1]); aw.w = pk2(wb[2], wb[3]);
        const bf16x8 wf = __builtin_bit_cast(bf16x8, aw);
#pragma unroll
        for (int nb = 0; nb < 8; ++nb) { const bf16x8 vf = *(const LAS bf16x8*)(vnT + (nb * 16 + fr) * 136 + kk * 32 + fq * 8);
            acc[nb] = __builtin_amdgcn_mfma_f32_16x16x32_bf16(vf, wf, acc[nb], 0, 0, 0); }
    }
    const size_t orow = (size_t)(G.r0 + G.wave * 16 + fr);
#pragma unroll
    for (int j = 0; j < 4; ++j) { const int d = g * 128 + 32 * fq + 8 * j;
        float uf[8], gf[8], y[8]; unpack8(o.uw[j], uf); unpack8(o.gw[j], gf);
#pragma unroll
        for (int nb = 0; nb < 8; ++nb) y[nb] = uf[nb] * (acc[nb][j] + o.bias) * silu_f(gf[nb]);
        *(v4u*)(G.Yb + orow * DM + ATTN_W + CONV_W + d) = pack8(y); }
}
__device__ __forceinline__ void phase_t1_gmlp(LAS unsigned char* lds, int l, int wv) {
    const Ctx c = fresh_ctx(wv); const bool last = (l == DEPTH - 1); const int lane = c.lane, wave = c.wave;
    GmCtx G; G.l = l; G.wave = wave; G.fr = lane & 15; G.fq = lane >> 4; G.Pb = (const bf16*)(c.ws + WS_P); G.Yb = (bf16*)(c.ws + WS_Y);
    G.lng = c.ap->in[10] + l * GM_W; G.lnb = c.ap->in[11] + l * GM_W; G.gm_ws = c.ap->in[12]; G.gm_b = c.ap->in[13];
    const int nunits = (last ? NLAT : MT) / 128 * 4;
    LAS bf16* vnT0 = (LAS bf16*)(lds + RING_OFF); LAS bf16* vnT1 = vnT0 + 128 * 136;
    const int fr = G.fr, fq = G.fq;
#pragma unroll 1
    for (int uu = c.vcu; uu < nunits; uu += c.G) {
        const int cch = uu >> 2, gp = uu & 3; G.r0 = cch * 128;
        GmOps A; gm_load(A, G, 2 * gp);
        float mean[4], rstd[4];
#pragma unroll
        for (int hb = 0; hb < 2; ++hb) {
            v4u rv[2][8];
#pragma unroll
            for (int bt = 0; bt < 2; ++bt) { const bf16* Pv = G.Pb + (size_t)(G.r0 + wave * 16 + (hb * 2 + bt) * 4 + fq) * INC + C_GV;
#pragma unroll
                for (int j = 0; j < 8; ++j) rv[bt][j] = *(const v4u*)(Pv + j * 128 + fr * 8); }
#pragma unroll
            for (int bt = 0; bt < 2; ++bt) {
                float sm = 0.f;
#pragma unroll
                for (int j = 0; j < 8; ++j) { float f[8]; unpack8(rv[bt][j], f);
#pragma unroll
                    for (int e = 0; e < 8; ++e) sm += f[e]; }
                const float mn = sum16(sm) * (1.0f / 1024.0f);
                float q = 0.f;
#pragma unroll
                for (int j = 0; j < 8; ++j) { float f[8]; unpack8(rv[bt][j], f);
#pragma unroll
                    for (int e = 0; e < 8; ++e) { const float d0 = f[e] - mn; q += d0 * d0; } }
                mean[hb * 2 + bt] = mn; rstd[hb * 2 + bt] = 1.0f / sqrtf(sum16(q) * (1.0f / 1024.0f) + EPS); }
        }
        gm_norm(A, G, mean, rstd, vnT0);
        GmOps B; gm_load(B, G, 2 * gp + 1);
        __syncthreads();
        gm_mma_epi(A, G, 2 * gp, vnT0);
        gm_norm(B, G, mean, rstd, vnT1);
        __syncthreads();
        gm_mma_epi(B, G, 2 * gp + 1, vnT1);
    }
    __syncthreads();
}
__device__ __forceinline__ void phase_attn(char* lds_generic, int l, int wv) {
    const Ctx c = fresh_ctx(wv); const bool last = (l == DEPTH - 1);
    const bf16* Pb = (const bf16*)(c.ws + WS_P); const bf16* Qb = (const bf16*)(c.ws + WS_Q); const bf16* Kb = (const bf16*)(c.ws + WS_K); const bf16* Vb = (const bf16*)(c.ws + WS_V); bf16* Yb = (bf16*)(c.ws + WS_Y);
    const int NU = 512 + (last ? 0 : 32);
    for (int i = c.vcu; i < NU; i += c.G) {
        int b, h, row0, seq;
        if (i < 512) { b = i >> 8; h = ((i >> 6) & 3) * 4 + ((i >> 4) & 3); row0 = b * SEQ + (i & 15) * 256; seq = SKV; }
        else { const int e = i - 512; b = e >> 4; h = e & 15; row0 = NLAT + b * CTXL; seq = CTXL; }
        const int kvh = h >> 2;
        int tfresh = c.tid; asm volatile("" : "+v"(tfresh));
        attn::attn_dense_body((const attn::bf16*)(Qb + (size_t)row0 * ATTN_W + h * HD), (const attn::bf16*)(Kb + (size_t)b * SKV * KV_W + kvh * HD),
                              (const attn::bf16*)(Vb + (size_t)b * SKV * KV_W + kvh * HD), Pb + (size_t)row0 * INC + C_AG + h * HD, Yb + (size_t)row0 * DM + h * HD, seq, lds_generic + RING_OFF, tfresh);
    }
}
__device__ __forceinline__ void phase_g2(LAS unsigned char* lds, int l, int wv) {
    const Ctx c = fresh_ctx(wv); const bool last = (l == DEPTH - 1);
    pg8::Order S; S.init(last ? 32 : 34, DM / 256, c.G, c.vcu, 0); S.panel = 1;
    pg8::Gemm g{(const bf16*)(c.ws + WS_Y), (const bf16*)(c.ws + WS_WBR + l * WBR_L), DM, DM, DM};
    pg8::EpiMerge E{(const bf16*)(c.ws + WS_P) + C_MG, INC, c.ws + WS_MG8, DM, (unsigned*)(c.ws + WS_CTL + CTL_ROWMAX) + l * MT,
                    (unsigned*)(c.ws + WS_CTL + CTL_PCNT) + l * 64 * 64, 16u * 8u, (float*)(c.ws + WS_SM), (unsigned*)(c.ws + WS_CTL) + 2};
    pg8::gemm_phase<pg8::EpiMerge, pg8::Order, true, true, false>(lds + RING_OFF, g, S, E, c.tid);
}
__device__ __forceinline__ void phase_mq(int l, int wv) {
    const Ctx c = fresh_ctx(wv);
    if (l == 0) modv_reduce(c, 1);
}
__device__ __forceinline__ void phase_g3(LAS unsigned char* lds, int l, int wv) {
    const Ctx c = fresh_ctx(wv); const bool last = (l == DEPTH - 1);
    const bf16* XC = (const bf16*)(c.ws + WS_XC);
    pg8::Gemm g{(const bf16*)(c.ws + WS_MG8), (const bf16*)(c.ws + WS_W8O + l * W8O_L), DM / 2, DM / 2, DM / 2};
    pg8::Order S; S.init(last ? 32 : 34, DM / 256, c.G, c.vcu, 0); S.panel = 1;
    if (last) { pg8::EpiResLnI8<true, true> E{c.ws, l, XC, XC + (size_t)NLAT * DM, c.ap->in[18] + l * DM, c.ap->in[19] + l * DM, c.ap->out};
        pg8::gemm_phase<pg8::EpiResLnI8<true, true>, pg8::Order, true, true, true>(lds + RING_OFF, g, S, E, c.tid); }
    else { pg8::EpiResLnI8<false, false> E{c.ws, l, c.ap->in[0], c.ap->in[2], c.ap->in[18] + l * DM, c.ap->in[19] + l * DM, nullptr};
        pg8::gemm_phase<pg8::EpiResLnI8<false, false>, pg8::Order, true, true, true>(lds + RING_OFF, g, S, E, c.tid); }
}
__device__ __forceinline__ void phase_q1(int wv) {
    const Ctx c = fresh_ctx(wv);
    quantize_w8(c, 1, 0, NI8 + DM);
}
__global__ void __launch_bounds__(NWAVES * 64, 2) mega_fwd(Args args) {
    extern __shared__ __attribute__((aligned(16))) unsigned char lds_raw[];
    LAS unsigned char* lds = (LAS unsigned char*)lds_raw;
    volatile LAS unsigned* MISC = (volatile LAS unsigned*)(lds + MISC_OFF);
    for (int u = threadIdx.x; u < (LDS_BYTES - LDSCTL_OFF) / 4; u += NWAVES * 64) ((LAS unsigned*)(lds + LDSCTL_OFF))[u] = 0u;
    __syncthreads();
    (void)xcd_barrier_post((unsigned*)(args.ws + WS_CTL) + CW_BAR, MISC + 8);
    const int wv = __builtin_amdgcn_readfirstlane((int)threadIdx.x >> 6);
#define GRID_BAR() do { ArgsP ap_ = (ArgsP)__builtin_amdgcn_kernarg_segment_ptr(); asm volatile("" : "+s"(ap_)); XcdBarrier b_; b_.bar = (unsigned*)(ap_->ws + WS_CTL) + CW_BAR; b_.x = xb_xcc_id(); \
        b_.st = (volatile LAS unsigned*)(lds + MISC_OFF) + 8; xcd_barrier(b_, wv == 0 && lane_id_fresh() == 0); } while (0)
    phase_p0(lds, wv);
    GRID_BAR();
    phase_p1(wv);
    GRID_BAR();
    phase_p2(wv);
    GRID_BAR();
#pragma nounroll
    for (int l = 0; l < DEPTH; ++l) {
        phase_g1a(lds, l, wv);
        phase_g1b(lds, l, wv);
        if (l == 0) phase_tail_transposes(lds, 0, wv);
        GRID_BAR();
        phase_t1_rows(l, wv);
        phase_t1_gmlp(lds, l, wv);
        GRID_BAR();
        phase_attn((char*)lds_raw, l, wv);
        GRID_BAR();
        phase_g2(lds, l, wv);
        if (l == 0) phase_tail_transposes(lds, 1, wv);
        GRID_BAR();
        if (l == 0) { phase_mq(l, wv); GRID_BAR(); }
        phase_g3(lds, l, wv);
        if (l == 0) phase_tail_transposes(lds, 2, wv);
        if (l != DEPTH - 1) GRID_BAR();
    }
#undef GRID_BAR
}

extern "C" void kernel_launch(void* const* d_in, const int* in_sizes, int n_in, void* d_out, int out_size, void* d_ws, size_t ws_size, hipStream_t stream) {
    static int grid = 0;
    if (grid == 0) {
        if (n_in != 20 || in_sizes[0] != NLAT * DM || out_size != NLAT * DM || ws_size < WS_END) {
            fprintf(stderr, "kernel_launch: shape mismatch: n_in %d in0 %d out %d ws %zu (need >= %zu)\n", n_in, n_in > 0 ? in_sizes[0] : -1, out_size, ws_size, (size_t)WS_END); grid = -1; return; }
        int dev = 0, cus = 0, per_cu = 0;
        if (hipGetDevice(&dev) != hipSuccess || hipDeviceGetAttribute(&cus, hipDeviceAttributeMultiprocessorCount, dev) != hipSuccess) { fprintf(stderr, "kernel_launch: device query failed\n"); grid = -1; return; }
        if (hipFuncSetAttribute((const void*)mega_fwd, hipFuncAttributeMaxDynamicSharedMemorySize, LDS_BYTES) != hipSuccess) { fprintf(stderr, "kernel_launch: hipFuncSetAttribute failed\n"); grid = -1; return; }
        if (hipOccupancyMaxActiveBlocksPerMultiprocessor(&per_cu, (const void*)mega_fwd, NWAVES * 64, LDS_BYTES) != hipSuccess || per_cu < 1)
            fprintf(stderr, "kernel_launch: note: occupancy query reports %d workgroups per CU\n", per_cu);
        (void)hipGetLastError();
        grid = cus;
    }
    if (grid < 0) return;
    if (hipMemsetAsync((char*)d_ws + WS_CTL, 0, CTL_ZERO_BYTES, stream) != hipSuccess) { fprintf(stderr, "kernel_launch: hipMemsetAsync failed\n"); return; }
    Args a{};
    for (int i = 0; i < 20; ++i) a.in[i] = (const float*)d_in[i];
    a.out = (float*)d_out; a.ws = (unsigned char*)d_ws;
    hipLaunchKernelGGL(mega_fwd, dim3(grid), dim3(NWAVES * 64), LDS_BYTES, stream, a);
    const hipError_t le = hipPeekAtLastError();
    if (le != hipSuccess) fprintf(stderr, "kernel_launch: launch failed: %s\n", hipGetErrorName(le));
}
```

```cpp
#include <hip/hip_runtime.h>
#include <hip/hip_bf16.h>
#include <cstdio>
#include <cstdint>
#include <cmath>

constexpr int DM = 4096, NB = 2, SEQ = 4096, CTXL = 256, DEPTH = 2;
constexpr int NLAT = NB * SEQ, NCTX = NB * CTXL, MT = NLAT + NCTX;
constexpr int HD = 128, NQH = 16, NKVH = 4, ATTN_W = 2048, KV_W = 512, CONV_W = 1024, GM_W = 1024;
constexpr int INC = 24576;
constexpr int C_Q = 0, C_K = 2048, C_V = 2560, C_AG = 3072, C_CB = 5120, C_CC = 6144, C_CH = 7168, C_CG = 8192, C_GU = 9216, C_GV = 10240, C_GG = 11264, C_MG = 12288;
constexpr int C_BF0 = 5120, C_BF1 = 12288, NI8 = INC - (C_BF1 - C_BF0);
constexpr int SKV = CTXL + SEQ;
constexpr float EPS = 1e-6f;
constexpr float ALPHA_RES = 1.4142135623730951f;

constexpr size_t MiB = 1u << 20;
constexpr size_t WS_CTL = 0, CTL_ZERO_BYTES = 1 * MiB;
constexpr size_t WS_ROPE = 1 * MiB;
constexpr size_t WS_MOD = 2 * MiB;
constexpr int NKC = 64;
constexpr size_t WS_MODP = 4 * MiB;
constexpr size_t WS_WIN = 32 * MiB, WIN_L = 192 * MiB;
constexpr size_t WS_WBR = 416 * MiB, WBR_L = 32 * MiB;
constexpr size_t WS_WOUT = 480 * MiB, WOUT_L = 32 * MiB;
constexpr size_t WS_U = 544 * MiB;
constexpr size_t WS_P = 612 * MiB;
constexpr size_t WS_Q = 1020 * MiB;
constexpr size_t WS_K = 1054 * MiB, WS_V = 1063 * MiB;
constexpr size_t WS_Y = 1072 * MiB;
constexpr size_t WS_MG = 1140 * MiB;
constexpr size_t WS_MGF = 1208 * MiB;
constexpr size_t WS_R = 1344 * MiB;
constexpr size_t WS_XC = 1480 * MiB;
constexpr size_t WS_U8 = 1616 * MiB;
constexpr size_t WS_W8 = 1652 * MiB, W8_L = 68 * MiB;
constexpr size_t WS_SU = 1790 * MiB;
constexpr size_t WS_SW = 1791 * MiB;
constexpr size_t WS_W8O = 1792 * MiB, W8O_L = 16 * MiB;
constexpr size_t WS_MG8 = 1824 * MiB;
constexpr size_t WS_PMAXO = 1858 * MiB;
constexpr size_t WS_SWO = 1861 * MiB;
constexpr size_t WS_SM = 1862 * MiB;
constexpr size_t WS_END = 1863 * MiB;
constexpr size_t CTL_RS = 327680;
constexpr size_t CTL_UMAX = 622592;
constexpr size_t CTL_PCNT2 = 671744;
constexpr size_t CTL_PCNT = 262144;
constexpr size_t CTL_ROWMAX = 131072;
constexpr size_t WS_PMAX = 22 * MiB;
constexpr int CW_BAR = 4096;

namespace pg8 {
#define PG8_LAS __attribute__((address_space(3)))
#define PG8_GAS __attribute__((address_space(1)))
typedef unsigned short bf16_t;
typedef short bf16x8 __attribute__((ext_vector_type(8)));
typedef float f32x4 __attribute__((ext_vector_type(4)));
typedef unsigned u32x4 __attribute__((ext_vector_type(4)));
constexpr int BM = 256, BK = 64, HALF = 128, HTB = HALF * BK * 2  , STAGE_BYTES = 8 * HTB, NXCD = 8, WGM = 4;

__host__ __device__ __forceinline__ int lds_byte(int r, int c) { const int st = (r >> 4) * 2 + (c >> 5), rr = r & 15, cc = c & 31, ob = rr * 64 + cc * 2; return st * 1024 + (ob ^ (((ob >> 9) & 1) << 5)); }
__host__ __device__ __forceinline__ void stage_rc(int b, int& R, int& C) { const int st = b / 1024, sb = b % 1024, swz = sb ^ (((sb >> 9) & 1) << 5); R = (st >> 1) * 16 + swz / 64; C = (st & 1) * 32 + (swz % 64) / 2; }
__host__ __device__ __forceinline__ int perm32(int rho) { const int n = rho >> 4, i = rho & 15; return 8 * (i >> 2) + 4 * n + (i & 3); }

struct Unit { int pm, pn; };
struct Gemm { const bf16_t* A; const bf16_t* Bt; int lda, ldb, K; };

struct Order {
    int nM, nN, nwg, G, c, nextra;
    int noremap = 0;
    int panel = 0;
    int full, rem, n3;
    __host__ __device__ void init(int nM_, int nN_, int G_, int c_, int nextra_, int n3_ = 0) { nM = nM_; nN = nN_; nwg = nM * nN; G = G_; c = c_; nextra = nextra_;
        const int tot = nwg + nextra; full = tot / G; rem = tot % G; n3 = n3_ > 0 ? n3_ : G; }
    int seg = 0, sn0 = 0, sw0 = 0, sn1 = 0, sw1 = 0, sn2 = 0, sw2 = 0;
    __host__ __device__ bool next(int i, Unit& u) const {
        long L;
        if (seg) { int w, base;
            if (i < sn0) { w = sw0; base = i * sw0; } else if (i < sn0 + sn1) { w = sw1; base = sn0 * sw0 + (i - sn0) * sw1; } else if (i < sn0 + sn1 + sn2) { w = sw2; base = sn0 * sw0 + sn1 * sw1 + (i - sn0 - sn1) * sw2; } else return false;
            if (c >= w) return false;
            L = base + c; if (L >= nwg + nextra) return false; }
        else if (i < full) L = (long)i * G + c;
        else { const int idx = (i - full) * n3 + c; if (c >= n3 || idx >= rem) return false; L = (long)full * G + idx; }
        if (L >= nwg) { const int e = (int)(L - nwg); u.pm = 32 + (e >> 2); u.pn = 8 + (e & 3); return true; }
        if (panel) { u.pm = (int)(L / nN); u.pn = (int)(L % nN); return true; }
        int wgid = (int)L; if (!noremap) { const int q = nwg / NXCD, r = nwg % NXCD, xcd = wgid % NXCD, off = wgid / NXCD; wgid = (xcd < r ? xcd * (q + 1) : r * (q + 1) + (xcd - r) * q) + off; }
        const int nig = WGM * nN, gid = wgid / nig, fm = gid * WGM, gsz = (nM - fm) < WGM ? (nM - fm) : WGM;
        u.pm = fm + ((wgid % nig) % gsz); u.pn = (wgid % nig) / gsz; return true;
    }
    __device__ __forceinline__ void a_ready(const Unit&) const {}
    __device__ __forceinline__ void done(const Unit&) const {}
};

typedef float f32x2_t_ __attribute__((ext_vector_type(2)));
typedef __bf16 bf16x2_t_ __attribute__((ext_vector_type(2)));
__device__ __forceinline__ unsigned cvt_pk_bf16(float lo, float hi) { const f32x2_t_ v = {lo, hi}; return __builtin_bit_cast(unsigned, __builtin_convertvector(v, bf16x2_t_)); }
__device__ __forceinline__ float bf_lo(unsigned w) { return __uint_as_float(w << 16); }
__device__ __forceinline__ float bf_hi(unsigned w) { return __uint_as_float(w & 0xffff0000u); }
__device__ __forceinline__ float sigmoidf_(float x) { return __builtin_amdgcn_rcpf(1.0f + __expf(-x)); }

struct EpiBf16 {
    static constexpr bool PERM = true, AFTER_DRAIN = false;
    bf16_t* O; int ldc; int sig_from;
    __device__ __forceinline__ void operator()(const f32x4 (&acc)[2][2][4][2], const Unit& u, int wr, int wc, int fr, int fq) const {
        const int row0 = u.pm * BM + wr * 64 + fr, col0 = u.pn * BM + wc * 32 + 8 * fq;
#pragma unroll
        for (int ai = 0; ai < 2; ++ai)
#pragma unroll
            for (int m = 0; m < 4; ++m) { bf16_t* rowp = O + (size_t)(row0 + ai * HALF + m * 16) * ldc + col0;
#pragma unroll
                for (int bj = 0; bj < 2; ++bj) { f32x4 v0 = acc[ai][bj][m][0], v1 = acc[ai][bj][m][1];
                    if (u.pn >= sig_from) {
#pragma unroll
                        for (int e = 0; e < 4; ++e) { v0[e] = sigmoidf_(v0[e]); v1[e] = sigmoidf_(v1[e]); } }
                    u32x4 w; w.x = cvt_pk_bf16(v0[0], v0[1]); w.y = cvt_pk_bf16(v0[2], v0[3]); w.z = cvt_pk_bf16(v1[0], v1[1]); w.w = cvt_pk_bf16(v1[2], v1[3]);
                    *(u32x4*)(rowp + bj * HALF) = w; } }
    }
};
__device__ __forceinline__ void panel_wait(PG8_GAS unsigned* pc, unsigned need, PG8_GAS unsigned* tmo, int wr, int wc, int lane_) {
    asm volatile("s_waitcnt vmcnt(0) lgkmcnt(0)" ::: "memory");
    if (lane_ == 0) __hip_atomic_fetch_add(pc, 1u, __ATOMIC_RELAXED, __HIP_MEMORY_SCOPE_AGENT);
    if (wr == 0 && wc == 0) { unsigned spins = 0;
        while ((unsigned)__builtin_amdgcn_readfirstlane(__hip_atomic_load(pc, __ATOMIC_RELAXED, __HIP_MEMORY_SCOPE_AGENT)) < need) {
            __builtin_amdgcn_s_sleep(1);
            if (++spins > (1u << 20)) { if (lane_ == 0) __hip_atomic_store(tmo, 1u, __ATOMIC_RELAXED, __HIP_MEMORY_SCOPE_AGENT); break; } } }
    asm volatile("" ::: "memory"); __builtin_amdgcn_s_barrier(); asm volatile("" ::: "memory");
}
struct EpiMerge {
    static constexpr bool PERM = true, AFTER_DRAIN = false, HAS_MID = true;
    static constexpr int SEAM0 = ATTN_W / BK, SEAM1 = (ATTN_W + CONV_W) / BK;
    const bf16_t* gate; int ldg; unsigned char* mg8; int ldc; unsigned* rowmax; unsigned* pcnt; unsigned need; float* sm; unsigned* tmo;
    __device__ __forceinline__ void seam_mul(f32x4 (&acc)[2][2][4][2], int ai, int m, int bj, const u32x4 a, const u32x4 b) const {
        f32x4 r0, r1;
        r0[0] = bf_lo(a.x) * __builtin_amdgcn_rcpf(fmaxf(bf_lo(b.x), 1e-6f)); r0[1] = bf_hi(a.x) * __builtin_amdgcn_rcpf(fmaxf(bf_hi(b.x), 1e-6f));
        r0[2] = bf_lo(a.y) * __builtin_amdgcn_rcpf(fmaxf(bf_lo(b.y), 1e-6f)); r0[3] = bf_hi(a.y) * __builtin_amdgcn_rcpf(fmaxf(bf_hi(b.y), 1e-6f));
        r1[0] = bf_lo(a.z) * __builtin_amdgcn_rcpf(fmaxf(bf_lo(b.z), 1e-6f)); r1[1] = bf_hi(a.z) * __builtin_amdgcn_rcpf(fmaxf(bf_hi(b.z), 1e-6f));
        r1[2] = bf_lo(a.w) * __builtin_amdgcn_rcpf(fmaxf(bf_lo(b.w), 1e-6f)); r1[3] = bf_hi(a.w) * __builtin_amdgcn_rcpf(fmaxf(bf_hi(b.w), 1e-6f));
        acc[ai][bj][m][0] *= r0; acc[ai][bj][m][1] *= r1;
    }
    __device__ __forceinline__ void mid(f32x4 (&acc)[2][2][4][2], const Unit& u, int seg, int wr, int wc, int fr, int fq) const {
        asm volatile("" : "+v"(fr), "+v"(fq));
        const int row0 = u.pm * BM + wr * 64 + fr, col0 = u.pn * BM + wc * 32 + 8 * fq;
        u32x4 ga[4][2], gb[4][2], ha[4][2], hb[4][2];
#pragma unroll
        for (int m = 0; m < 4; ++m) { const bf16_t* gp = gate + (size_t)(row0 + m * 16) * ldg + seg * DM + col0;
#pragma unroll
            for (int bj = 0; bj < 2; ++bj) { ga[m][bj] = *(const u32x4*)(gp + bj * HALF); gb[m][bj] = *(const u32x4*)(gp + DM + bj * HALF); } }
#pragma unroll
        for (int m = 0; m < 4; ++m) {
#pragma unroll
            for (int bj = 0; bj < 2; ++bj) seam_mul(acc, 0, m, bj, ga[m][bj], gb[m][bj]);
            const bf16_t* gp = gate + (size_t)(row0 + HALF + m * 16) * ldg + seg * DM + col0;
#pragma unroll
            for (int bj = 0; bj < 2; ++bj) { ha[m][bj] = *(const u32x4*)(gp + bj * HALF); hb[m][bj] = *(const u32x4*)(gp + DM + bj * HALF); } }
#pragma unroll
        for (int m = 0; m < 4; ++m)
#pragma unroll
            for (int bj = 0; bj < 2; ++bj) seam_mul(acc, 1, m, bj, ha[m][bj], hb[m][bj]);
    }
    __device__ __forceinline__ void operator()(const f32x4 (&acc)[2][2][4][2], const Unit& u, int wr, int wc, int fr, int fq) const {
        const int row0 = u.pm * BM + wr * 64 + fr, col0 = u.pn * BM + wc * 32 + 8 * fq;
        f32x4 v[2][2][4][2];
#pragma unroll
        for (int ai = 0; ai < 2; ++ai) { u32x4 gl[4][2];
#pragma unroll
            for (int m = 0; m < 4; ++m)
#pragma unroll
                for (int bj = 0; bj < 2; ++bj) gl[m][bj] = *(const u32x4*)(gate + (size_t)(row0 + ai * HALF + m * 16) * ldg + 2 * DM + col0 + bj * HALF);
#pragma unroll
            for (int m = 0; m < 4; ++m) { const size_t row = (size_t)(row0 + ai * HALF + m * 16); float rmx = 0.f;
#pragma unroll
                for (int bj = 0; bj < 2; ++bj) { const int col = col0 + bj * HALF;
                    const u32x4 gv = gl[m][bj];
                    f32x4 g0, g1;
                    g0[0] = fmaxf(bf_lo(gv.x), 1e-6f); g0[1] = fmaxf(bf_hi(gv.x), 1e-6f); g0[2] = fmaxf(bf_lo(gv.y), 1e-6f); g0[3] = fmaxf(bf_hi(gv.y), 1e-6f);
                    g1[0] = fmaxf(bf_lo(gv.z), 1e-6f); g1[1] = fmaxf(bf_hi(gv.z), 1e-6f); g1[2] = fmaxf(bf_lo(gv.w), 1e-6f); g1[3] = fmaxf(bf_hi(gv.w), 1e-6f);
                    v[ai][bj][m][0] = acc[ai][bj][m][0] * g0; v[ai][bj][m][1] = acc[ai][bj][m][1] * g1;
#pragma unroll
                    for (int e = 0; e < 4; ++e) rmx = fmaxf(rmx, fmaxf(__builtin_fabsf(v[ai][bj][m][0][e]), __builtin_fabsf(v[ai][bj][m][1][e]))); }
                rmx = fmaxf(rmx, __shfl_xor(rmx, 16)); rmx = fmaxf(rmx, __shfl_xor(rmx, 32));
                if (fq == 0) __hip_atomic_fetch_max((PG8_GAS unsigned*)rowmax + row, __float_as_uint(rmx), __ATOMIC_RELAXED, __HIP_MEMORY_SCOPE_AGENT); } }
        panel_wait((PG8_GAS unsigned*)pcnt + 64 * u.pm, need, (PG8_GAS unsigned*)tmo, wr, wc, fr + 16 * fq);
        float mx8[2][4];
#pragma unroll
        for (int ai = 0; ai < 2; ++ai)
#pragma unroll
            for (int m = 0; m < 4; ++m) mx8[ai][m] = __uint_as_float(__hip_atomic_load((PG8_GAS unsigned*)rowmax + (size_t)(row0 + ai * HALF + m * 16), __ATOMIC_RELAXED, __HIP_MEMORY_SCOPE_AGENT));
#pragma unroll
        for (int ai = 0; ai < 2; ++ai)
#pragma unroll
            for (int m = 0; m < 4; ++m) { const size_t row = (size_t)(row0 + ai * HALF + m * 16);
                const float mx = mx8[ai][m];
                const float sc = mx > 0.f ? mx * (1.0f / 127.0f) : 1.0f, inv = 1.0f / sc;
                if (u.pn == 0 && wc == 0 && fq == 0) __hip_atomic_store((PG8_GAS float*)sm + row, sc, __ATOMIC_RELAXED, __HIP_MEMORY_SCOPE_AGENT);
#pragma unroll
                for (int bj = 0; bj < 2; ++bj) { int q[8];
#pragma unroll
                    for (int e = 0; e < 4; ++e) { q[e] = __float2int_rn(v[ai][bj][m][0][e] * inv); q[4 + e] = __float2int_rn(v[ai][bj][m][1][e] * inv); }
                    unsigned w0 = (unsigned)(q[0] & 255) | ((unsigned)(q[1] & 255) << 8) | ((unsigned)(q[2] & 255) << 16) | ((unsigned)(q[3] & 255) << 24);
                    unsigned w1 = (unsigned)(q[4] & 255) | ((unsigned)(q[5] & 255) << 8) | ((unsigned)(q[6] & 255) << 16) | ((unsigned)(q[7] & 255) << 24);
                    typedef unsigned u32x2_ __attribute__((ext_vector_type(2)));
                    *(u32x2_*)(mg8 + row * ldc + col0 + bj * HALF) = (u32x2_){w0, w1}; } }
    }
};
typedef int i32x4 __attribute__((ext_vector_type(4)));
template <class E, class = void> struct HasMid { static constexpr bool value = false; };
template <class E> struct HasMid<E, decltype((void)E::HAS_MID)> { static constexpr bool value = E::HAS_MID; };
template <bool I8> struct AccT;
template <> struct AccT<false> { typedef f32x4 type; static __device__ __forceinline__ f32x4 zero() { return (f32x4){0.f, 0.f, 0.f, 0.f}; } };
template <> struct AccT<true>  { typedef i32x4 type; static __device__ __forceinline__ i32x4 zero() { return (i32x4){0, 0, 0, 0}; } };
template <bool I8> __device__ __forceinline__ void mma1(typename AccT<I8>::type& c, const bf16x8& a, const bf16x8& b);
template <> __device__ __forceinline__ void mma1<false>(f32x4& c, const bf16x8& a, const bf16x8& b) { c = __builtin_amdgcn_mfma_f32_16x16x32_bf16(a, b, c, 0, 0, 0); }
template <> __device__ __forceinline__ void mma1<true>(i32x4& c, const bf16x8& a, const bf16x8& b) { c = __builtin_amdgcn_mfma_i32_16x16x64_i8(__builtin_bit_cast(i32x4, a), __builtin_bit_cast(i32x4, b), c, 0, 0, 0); }
struct EpiGateI8 {
    static constexpr bool PERM = true, AFTER_DRAIN = false;
    bf16_t* O; int ldc; const float* su; const float* sw;
    __device__ __forceinline__ void operator()(const i32x4 (&acc)[2][2][4][2], const Unit& u, int wr, int wc, int fr, int fq) const {
        const bool gate = u.pn >= C_BF0 / 256;
        const int row0 = u.pm * BM + wr * 64 + fr, cw = u.pn * BM + wc * 32 + 8 * fq, col0 = cw + (gate ? (C_BF1 - C_BF0) : 0);
        f32x4 cs[2][2];
#pragma unroll
        for (int bj = 0; bj < 2; ++bj)
#pragma unroll
            for (int n = 0; n < 2; ++n) cs[bj][n] = *(const f32x4*)(sw + cw + bj * HALF + 4 * n);
        float rs8[2][4];
#pragma unroll
        for (int ai = 0; ai < 2; ++ai)
#pragma unroll
            for (int m = 0; m < 4; ++m) rs8[ai][m] = su[row0 + ai * HALF + m * 16];
#pragma unroll
        for (int ai = 0; ai < 2; ++ai)
#pragma unroll
            for (int m = 0; m < 4; ++m) { const int row = row0 + ai * HALF + m * 16; const float rs = rs8[ai][m]; bf16_t* rowp = O + (size_t)row * ldc + col0;
#pragma unroll
                for (int bj = 0; bj < 2; ++bj) { f32x4 v0, v1;
#pragma unroll
                    for (int e = 0; e < 4; ++e) { v0[e] = (float)acc[ai][bj][m][0][e] * rs * cs[bj][0][e]; v1[e] = (float)acc[ai][bj][m][1][e] * rs * cs[bj][1][e]; }
                    if (gate) {
#pragma unroll
                        for (int e = 0; e < 4; ++e) { v0[e] = sigmoidf_(v0[e]); v1[e] = sigmoidf_(v1[e]); } }
                    u32x4 w; w.x = cvt_pk_bf16(v0[0], v0[1]); w.y = cvt_pk_bf16(v0[2], v0[3]); w.z = cvt_pk_bf16(v1[0], v1[1]); w.w = cvt_pk_bf16(v1[2], v1[3]);
                    *(u32x4*)(rowp + bj * HALF) = w; } }
    }
};

template <bool XBF, bool LAST> struct EpiResLnI8 {
    static constexpr bool PERM = true, AFTER_DRAIN = false;
    unsigned char* ws; int l; const void* xlat; const void* xctx; const float* lg; const float* lb; float* out;
    __device__ __forceinline__ void operator()(i32x4 (&acc)[2][2][4][2], const Unit& u, int wr, int wc, int fr, int fq) const {
        asm volatile("" : "+v"(fr), "+v"(fq));
        unsigned char* w_ = ws; int l_ = l; asm volatile("" : "+s"(w_), "+s"(l_));
        PG8_GAS unsigned char* wg = (PG8_GAS unsigned char*)w_;
        const PG8_GAS float* modv = (const PG8_GAS float*)(wg + WS_MOD) + l_ * 3 * 12288; const PG8_GAS float* mod1 = (const PG8_GAS float*)(wg + WS_MOD) + 3 * 12288; const float alpha = ALPHA_RES;
        const PG8_GAS float* sm = (const PG8_GAS float*)(wg + WS_SM); const PG8_GAS float* swo = (const PG8_GAS float*)(wg + WS_SWO) + l_ * DM;
        PG8_GAS bf16_t* xc = (PG8_GAS bf16_t*)(wg + WS_XC); PG8_GAS bf16_t* U = (PG8_GAS bf16_t*)(wg + WS_U); PG8_GAS unsigned char* U8 = wg + WS_U8; PG8_GAS float* su = (PG8_GAS float*)(wg + WS_SU);
        PG8_GAS unsigned long long* rs = (PG8_GAS unsigned long long*)(wg + WS_CTL + CTL_RS) + (size_t)l_ * 2 * MT; PG8_GAS unsigned* umax = (PG8_GAS unsigned*)(wg + WS_CTL + CTL_UMAX);
        PG8_GAS unsigned* pcnt = (PG8_GAS unsigned*)(wg + WS_CTL + CTL_PCNT2) + (l_ * 2 + 0) * 64 * 64; PG8_GAS unsigned* pcnt2 = (PG8_GAS unsigned*)(wg + WS_CTL + CTL_PCNT2) + (l_ * 2 + 1) * 64 * 64;
        PG8_GAS unsigned* tmo = (PG8_GAS unsigned*)(wg + WS_CTL) + 2; const unsigned need = 16u * 8u;
        const PG8_GAS float* lgp = (const PG8_GAS float*)lg; const PG8_GAS float* lbp = (const PG8_GAS float*)lb; PG8_GAS float* outp = (PG8_GAS float*)out;
        const int row0 = u.pm * BM + wr * 64 + fr, col0 = u.pn * BM + wc * 32 + 8 * fq, lane_ = fr + 16 * fq;
        const int which = u.pm < 16 ? 0 : (u.pm < 32 ? 1 : 2);
        const PG8_GAS float* gt = modv + which * 12288 + 8192;
#define RR(ai, bj, m, n) __builtin_bit_cast(f32x4, acc[ai][bj][m][n])
#define RW(ai, bj, m, n, v) acc[ai][bj][m][n] = __builtin_bit_cast(i32x4, (v))
        {   f32x4 gv[2][2];
#pragma unroll
            for (int bj = 0; bj < 2; ++bj)
#pragma unroll
                for (int n = 0; n < 2; ++n) gv[bj][n] = *(const PG8_GAS f32x4*)(gt + col0 + bj * HALF + 4 * n) * *(const PG8_GAS f32x4*)(swo + col0 + bj * HALF + 4 * n);
#pragma unroll
            for (int ai = 0; ai < 2; ++ai)
#pragma unroll
            for (int mh = 0; mh < (XBF ? 1 : 2); ++mh) {
              constexpr int MB = XBF ? 4 : 2;
              const PG8_GAS void* xb = (const PG8_GAS void*)((u.pm < 32) ? xlat : xctx);
              float rsc4[MB]; u32x4 xq[MB][2]; f32x4 xf[XBF ? 1 : MB][XBF ? 1 : 2][2];
#pragma unroll
              for (int mm = 0; mm < MB; ++mm) { const int m = mh * MB + mm; const int row = row0 + ai * HALF + m * 16; rsc4[mm] = sm[row];
                  const size_t xoff = (u.pm < 32) ? (size_t)row * DM : (size_t)(row - 8192) * DM;
#pragma unroll
                  for (int bj = 0; bj < 2; ++bj) { const int col = col0 + bj * HALF;
                      if (XBF) xq[mm][bj] = *(const PG8_GAS u32x4*)((const PG8_GAS bf16_t*)xb + xoff + col);
                      else { xf[XBF ? 0 : mm][XBF ? 0 : bj][0] = *(const PG8_GAS f32x4*)((const PG8_GAS float*)xb + xoff + col); xf[XBF ? 0 : mm][XBF ? 0 : bj][1] = *(const PG8_GAS f32x4*)((const PG8_GAS float*)xb + xoff + col + 4); } } }
#pragma unroll
                for (int mm = 0; mm < MB; ++mm) { const int m = mh * MB + mm; const int row = row0 + ai * HALF + m * 16; const float rsc = rsc4[mm];
                    float s1 = 0.f, s2 = 0.f;
#pragma unroll
                    for (int bj = 0; bj < 2; ++bj) { f32x4 x0, x1;
                        if (XBF) { const u32x4 xv = xq[mm][bj];
                            x0[0] = bf_lo(xv.x); x0[1] = bf_hi(xv.x); x0[2] = bf_lo(xv.y); x0[3] = bf_hi(xv.y); x1[0] = bf_lo(xv.z); x1[1] = bf_hi(xv.z); x1[2] = bf_lo(xv.w); x1[3] = bf_hi(xv.w); }
                        else { x0 = xf[XBF ? 0 : mm][XBF ? 0 : bj][0]; x1 = xf[XBF ? 0 : mm][XBF ? 0 : bj][1]; }
                        f32x4 a0, a1;
#pragma unroll
                        for (int e = 0; e < 4; ++e) { a0[e] = (float)acc[ai][bj][m][0][e]; a1[e] = (float)acc[ai][bj][m][1][e]; }
                        const f32x4 r0 = x0 * alpha + gv[bj][0] * rsc * a0, r1 = x1 * alpha + gv[bj][1] * rsc * a1;
                        RW(ai, bj, m, 0, r0); RW(ai, bj, m, 1, r1);
#pragma unroll
                        for (int e = 0; e < 4; ++e) { s1 += r0[e] + r1[e]; s2 += r0[e] * r0[e] + r1[e] * r1[e]; } }
                    s1 += __shfl_xor(s1, 16); s1 += __shfl_xor(s1, 32); s2 += __shfl_xor(s2, 16); s2 += __shfl_xor(s2, 32);
                    if (fq == 0) { __hip_atomic_fetch_add(rs + row, (unsigned long long)(long long)__float2ll_rn(s1 * 1048576.0f), __ATOMIC_RELAXED, __HIP_MEMORY_SCOPE_AGENT); __hip_atomic_fetch_add(rs + MT + row, (unsigned long long)(long long)__float2ll_rn(s2 * 4096.0f), __ATOMIC_RELAXED, __HIP_MEMORY_SCOPE_AGENT); } }  } }
        panel_wait(pcnt + 64 * u.pm, need, tmo, wr, wc, lane_);
        float mean[8], rstd[8];
        unsigned long long sv1[8], sv2[8];
#pragma unroll
        for (int ai = 0; ai < 2; ++ai)
#pragma unroll
            for (int m = 0; m < 4; ++m) { const int row = row0 + ai * HALF + m * 16;
                sv1[ai * 4 + m] = __hip_atomic_load(rs + row, __ATOMIC_RELAXED, __HIP_MEMORY_SCOPE_AGENT); sv2[ai * 4 + m] = __hip_atomic_load(rs + MT + row, __ATOMIC_RELAXED, __HIP_MEMORY_SCOPE_AGENT); }
#pragma unroll
        for (int ai = 0; ai < 2; ++ai)
#pragma unroll
            for (int m = 0; m < 4; ++m) {
                const float S1 = (float)(long long)sv1[ai * 4 + m] * (1.0f / 1048576.0f), S2 = (float)(long long)sv2[ai * 4 + m] * (1.0f / 4096.0f);
                const float mu = S1 * (1.0f / DM); mean[ai * 4 + m] = mu; rstd[ai * 4 + m] = 1.0f / sqrtf(fmaxf(S2 * (1.0f / DM) - mu * mu, 0.f) + EPS); }
        typedef unsigned u32x2_ __attribute__((ext_vector_type(2)));
#pragma unroll
        for (int bj = 0; bj < 2; ++bj) {
            f32x4 gS[2], bS[2], cS[LAST ? 1 : 2], hS[LAST ? 1 : 2];
#pragma unroll
            for (int n = 0; n < 2; ++n) { const int col = col0 + bj * HALF + 4 * n;
                gS[n] = *(const PG8_GAS f32x4*)(lgp + col); bS[n] = *(const PG8_GAS f32x4*)(lbp + col);
                if (!LAST) { const PG8_GAS float* m1 = mod1 + which * 12288; cS[LAST ? 0 : n] = *(const PG8_GAS f32x4*)(m1 + DM + col); hS[LAST ? 0 : n] = *(const PG8_GAS f32x4*)(m1 + col); } }
#pragma unroll
            for (int n = 0; n < 2; ++n) { const int col = col0 + bj * HALF + 4 * n;
                const f32x4 g = gS[n], b = bS[n];
                f32x4 cc = g, hh = g;
                if (!LAST) { cc = cS[LAST ? 0 : n] + 1.0f; hh = hS[LAST ? 0 : n]; }
#pragma unroll
                for (int ai = 0; ai < 2; ++ai)
#pragma unroll
                    for (int m = 0; m < 4; ++m) { const unsigned eo = (unsigned)(row0 + ai * HALF + m * 16) * (unsigned)DM + (unsigned)col;
                        const f32x4 nn = (RR(ai, bj, m, n) - mean[ai * 4 + m]) * rstd[ai * 4 + m] * g + b;
                        if (LAST) *(PG8_GAS f32x4*)(outp + eo) = nn;
                        else { u32x2_ w; w.x = cvt_pk_bf16(nn[0], nn[1]); w.y = cvt_pk_bf16(nn[2], nn[3]); *(PG8_GAS u32x2_*)(xc + eo) = w;
                            const f32x4 uu = nn * cc + hh; RW(ai, bj, m, n, uu);
                            w.x = cvt_pk_bf16(uu[0], uu[1]); w.y = cvt_pk_bf16(uu[2], uu[3]); *(PG8_GAS u32x2_*)(U + eo) = w; } } } }
        if (!LAST) {
#pragma unroll
            for (int ai = 0; ai < 2; ++ai)
#pragma unroll
                for (int m = 0; m < 4; ++m) { float mx = 0.f;
#pragma unroll
                    for (int bj = 0; bj < 2; ++bj)
#pragma unroll
                        for (int n = 0; n < 2; ++n)
#pragma unroll
                            for (int e = 0; e < 4; ++e) mx = fmaxf(mx, __builtin_fabsf(RR(ai, bj, m, n)[e]));
                    mx = fmaxf(mx, __shfl_xor(mx, 16)); mx = fmaxf(mx, __shfl_xor(mx, 32));
                    if (fq == 0) __hip_atomic_fetch_max(umax + row0 + ai * HALF + m * 16, __float_as_uint(mx), __ATOMIC_RELAXED, __HIP_MEMORY_SCOPE_AGENT); }
            panel_wait(pcnt2 + 64 * u.pm, need, tmo, wr, wc, lane_);
            float umx8[2][4];
#pragma unroll
            for (int ai = 0; ai < 2; ++ai)
#pragma unroll
                for (int m = 0; m < 4; ++m) umx8[ai][m] = __uint_as_float(__hip_atomic_load(umax + (unsigned)(row0 + ai * HALF + m * 16), __ATOMIC_RELAXED, __HIP_MEMORY_SCOPE_AGENT));
#pragma unroll
            for (int ai = 0; ai < 2; ++ai)
#pragma unroll
                for (int m = 0; m < 4; ++m) { const unsigned row = (unsigned)(row0 + ai * HALF + m * 16);
                    const float mx = umx8[ai][m];
                    const float sc = mx > 0.f ? mx * (1.0f / 127.0f) : 1.0f, inv = 1.0f / sc;
                    if (u.pn == 0 && wc == 0 && fq == 0) __hip_atomic_store(su + row, sc, __ATOMIC_RELAXED, __HIP_MEMORY_SCOPE_AGENT);
#pragma unroll
                    for (int bj = 0; bj < 2; ++bj) { int q[8];
#pragma unroll
                        for (int e = 0; e < 4; ++e) { q[e] = __float2int_rn(RR(ai, bj, m, 0)[e] * inv); q[4 + e] = __float2int_rn(RR(ai, bj, m, 1)[e] * inv); }
                        const unsigned w0 = (unsigned)(q[0] & 255) | ((unsigned)(q[1] & 255) << 8) | ((unsigned)(q[2] & 255) << 16) | ((unsigned)(q[3] & 255) << 24);
                        const unsigned w1 = (unsigned)(q[4] & 255) | ((unsigned)(q[5] & 255) << 8) | ((unsigned)(q[6] & 255) << 16) | ((unsigned)(q[7] & 255) << 24);
                        *(PG8_GAS u32x2_*)(U8 + (row * (unsigned)DM + (unsigned)(col0 + bj * HALF))) = (u32x2_){w0, w1}; } }
        }
    }
};
#undef RR
#undef RW
template <class Epi, class Sched, bool ALIGN_EPI = false, bool SP2 = false, bool I8 = false>
__device__ __forceinline__ void gemm_phase(PG8_LAS unsigned char* lds, const Gemm g, const Sched& S, const Epi& E, const int tid) {
    const int wid = __builtin_amdgcn_readfirstlane(tid >> 6), lane = tid & 63, wr = wid >> 2, wc = wid & 3, fr = lane & 15, fq = lane >> 4;
    const int K = g.K, nt = K / BK;
    unsigned voffA[2], voffB[2];
#pragma unroll
    for (int i = 0; i < 2; ++i) { int R, C; stage_rc(tid * 16 + i * 8192, R, C); const int Rb = Epi::PERM ? ((R & ~31) + perm32(R & 31)) : R;
        voffA[i] = (unsigned)(R * g.lda + C) * 2u; voffB[i] = (unsigned)(Rb * g.ldb + C) * 2u; }
    const size_t kstep = (size_t)(BK * 2);
    const size_t hstepA = (size_t)HALF * g.lda * 2, hstepB = (size_t)HALF * g.ldb * 2;
    const size_t tstepA = 2 * hstepA, tstepB = 2 * hstepB;
    const unsigned ldsw = (unsigned)wid * 1024u;
    const int aoff = lds_byte(wr * 64 + fr, fq * 8), boff = lds_byte(wc * 32 + fr, fq * 8);
#define PG8_SA(b, h) (((b) * 2 + (h)) * HTB)
#define PG8_SB(b, h) ((4 + (b) * 2 + (h)) * HTB)
#define PG8_STAGE(bufoff, gbase, voff) do { _Pragma("unroll") for (int _i = 0; _i < 2; ++_i) \
        __builtin_amdgcn_global_load_lds((const unsigned*)((const char*)(gbase) + (voff)[_i]), (PG8_LAS unsigned*)(lds + (bufoff) + ldsw + _i * 8192), 16, 0, 0); } while (0)
#define PG8_LDA(dst, b, h) do { _Pragma("unroll") for (int m = 0; m < 4; ++m) _Pragma("unroll") for (int k = 0; k < 2; ++k) dst[m][k] = *(const PG8_LAS bf16x8*)(lds + PG8_SA(b, h) + aoff + m * 2048 + k * 1024); } while (0)
#define PG8_LDB(dst, b, h) do { _Pragma("unroll") for (int n = 0; n < 2; ++n) _Pragma("unroll") for (int k = 0; k < 2; ++k) dst[n][k] = *(const PG8_LAS bf16x8*)(lds + PG8_SB(b, h) + boff + n * 2048 + k * 1024); } while (0)
#define PG8_MMA(ai, bj, At, Bt) do { __builtin_amdgcn_s_setprio(1); _Pragma("unroll") for (int m = 0; m < 4; ++m) _Pragma("unroll") for (int n = 0; n < 2; ++n) _Pragma("unroll") for (int k = 0; k < 2; ++k) \
        mma1<I8>(acc[ai][bj][m][n], Bt[n][k], At[m][k]); __builtin_amdgcn_s_setprio(0); } while (0)
#define PG8_WAIT_V(n) asm volatile("s_waitcnt vmcnt(" #n ")" ::: "memory")
#define PG8_WAIT_L(n) asm volatile("s_waitcnt lgkmcnt(" #n ")" ::: "memory")
#define PG8_BAR __builtin_amdgcn_s_barrier()
#define PG8_SCHED __builtin_amdgcn_sched_barrier(0)
    Unit cur, nxt; int ui = 0;
    if (!S.next(0, cur)) return;
    typename AccT<I8>::type acc[2][2][4][2];
#pragma unroll
    for (int a = 0; a < 2; ++a)
#pragma unroll
        for (int b = 0; b < 2; ++b)
#pragma unroll
            for (int m = 0; m < 4; ++m)
#pragma unroll
                for (int n = 0; n < 2; ++n) acc[a][b][m][n] = AccT<I8>::zero();
    bf16x8 At[4][2], B0[2][2], B1[2][2];
    const char* cA = (const char*)g.A + (size_t)cur.pm * tstepA; const char* cB = (const char*)g.Bt + (size_t)cur.pn * tstepB;
    S.a_ready(cur);
    if constexpr (SP2) {
        PG8_STAGE(PG8_SB(0, 0), cB, voffB); PG8_STAGE(PG8_SB(0, 1), cB + hstepB, voffB); PG8_STAGE(PG8_SA(0, 0), cA, voffA); PG8_STAGE(PG8_SA(0, 1), cA + hstepA, voffA);
        if (wr == 1) PG8_BAR;
        PG8_WAIT_V(2); PG8_BAR;
        PG8_STAGE(PG8_SB(1, 0), cB + kstep, voffB); PG8_STAGE(PG8_SA(1, 0), cA + kstep, voffA); PG8_STAGE(PG8_SB(1, 1), cB + hstepB + kstep, voffB);
        PG8_WAIT_V(6); PG8_BAR;
    } else {
        PG8_STAGE(PG8_SB(0, 0), cB, voffB); PG8_STAGE(PG8_SA(0, 0), cA, voffA); PG8_STAGE(PG8_SB(0, 1), cB + hstepB, voffB); PG8_STAGE(PG8_SA(0, 1), cA + hstepA, voffA);
        if (wr == 1) PG8_BAR;
        PG8_WAIT_V(4); PG8_BAR;
        PG8_STAGE(PG8_SB(1, 0), cB + kstep, voffB); PG8_STAGE(PG8_SA(1, 0), cA + kstep, voffA); PG8_STAGE(PG8_SB(1, 1), cB + hstepB + kstep, voffB);
        PG8_WAIT_V(6); PG8_BAR;
    }
    for (;;) {
        const bool has_next = S.next(ui + 1, nxt);
        const char* nA = has_next ? (const char*)g.A + (size_t)nxt.pm * tstepA : cA; const char* nB = has_next ? (const char*)g.Bt + (size_t)nxt.pn * tstepB : cB;
        for (int t = 0; t < nt; t += 2) {
            const bool last = (t == nt - 2);
            const char* a1 = cA + (size_t)(t + 1) * kstep;
            const char* a2 = last ? nA : cA + (size_t)(t + 2) * kstep; const char* b2 = last ? nB : cB + (size_t)(t + 2) * kstep;
            const char* a3 = a2 + kstep; const char* b3 = b2 + kstep;
            if (last && has_next) S.a_ready(nxt);
            if constexpr (SP2) {
            PG8_LDB(B0, 0, 0); PG8_LDB(B1, 0, 1); PG8_SCHED; PG8_LDA(At, 0, 0); PG8_STAGE(PG8_SA(1, 1), a1 + hstepA, voffA);
            PG8_WAIT_V(8); PG8_WAIT_L(0); PG8_BAR; PG8_MMA(0, 0, At, B0); PG8_MMA(0, 1, At, B1); PG8_BAR; PG8_SCHED;
            PG8_LDA(At, 0, 1); PG8_STAGE(PG8_SB(0, 0), b2, voffB); PG8_STAGE(PG8_SB(0, 1), b2 + hstepB, voffB); PG8_STAGE(PG8_SA(0, 0), a2, voffA);
            PG8_WAIT_V(8); PG8_WAIT_L(0); PG8_BAR; PG8_MMA(1, 0, At, B0); PG8_MMA(1, 1, At, B1); PG8_BAR; PG8_SCHED;
            PG8_LDB(B0, 1, 0); PG8_LDB(B1, 1, 1); PG8_SCHED; PG8_LDA(At, 1, 0); PG8_STAGE(PG8_SA(0, 1), a2 + hstepA, voffA);
            PG8_WAIT_V(8); PG8_WAIT_L(0); PG8_BAR; PG8_MMA(0, 0, At, B0); PG8_MMA(0, 1, At, B1); PG8_BAR; PG8_SCHED;
            PG8_LDA(At, 1, 1); PG8_STAGE(PG8_SB(1, 0), b3, voffB); PG8_STAGE(PG8_SB(1, 1), b3 + hstepB, voffB); PG8_STAGE(PG8_SA(1, 0), a3, voffA);
            PG8_WAIT_V(8); PG8_WAIT_L(0); PG8_BAR; PG8_MMA(1, 0, At, B0); PG8_MMA(1, 1, At, B1); PG8_BAR; PG8_SCHED;
            if constexpr (HasMid<Epi>::value) { if (t + 2 == Epi::SEAM0 || t + 2 == Epi::SEAM1) E.mid(acc, cur, t + 2 == Epi::SEAM0 ? 0 : 1, wr, wc, fr, fq); }
            } else {
            PG8_LDB(B0, 0, 0); PG8_SCHED; PG8_LDA(At, 0, 0); PG8_STAGE(PG8_SA(1, 1), a1 + hstepA, voffA);
            PG8_WAIT_L(8); PG8_BAR; PG8_WAIT_L(0); PG8_MMA(0, 0, At, B0); PG8_BAR; PG8_SCHED;
            PG8_LDB(B1, 0, 1); PG8_STAGE(PG8_SB(0, 0), b2, voffB);
            PG8_BAR; PG8_WAIT_L(0); PG8_MMA(0, 1, At, B1); PG8_BAR;
            PG8_LDA(At, 0, 1); PG8_STAGE(PG8_SA(0, 0), a2, voffA);
            PG8_BAR; PG8_WAIT_L(0); PG8_MMA(1, 0, At, B0); PG8_BAR; PG8_SCHED;
            PG8_STAGE(PG8_SB(0, 1), b2 + hstepB, voffB);
            PG8_WAIT_V(6); PG8_BAR; PG8_MMA(1, 1, At, B1); PG8_BAR;
            PG8_LDB(B0, 1, 0); PG8_SCHED; PG8_LDA(At, 1, 0); PG8_STAGE(PG8_SA(0, 1), a2 + hstepA, voffA);
            PG8_WAIT_L(8); PG8_BAR; PG8_WAIT_L(0); PG8_MMA(0, 0, At, B0); PG8_BAR; PG8_SCHED;
            PG8_LDB(B1, 1, 1); PG8_STAGE(PG8_SB(1, 0), b3, voffB);
            PG8_BAR; PG8_WAIT_L(0); PG8_MMA(0, 1, At, B1); PG8_BAR;
            PG8_LDA(At, 1, 1); PG8_STAGE(PG8_SA(1, 0), a3, voffA);
            PG8_BAR; PG8_WAIT_L(0); PG8_MMA(1, 0, At, B0); PG8_BAR; PG8_SCHED;
            PG8_STAGE(PG8_SB(1, 1), b3 + hstepB, voffB);
            PG8_WAIT_V(6); PG8_BAR; PG8_MMA(1, 1, At, B1); PG8_BAR;
            }
        }
        if constexpr (ALIGN_EPI) { if (wr == 0) PG8_BAR; }
        if constexpr (!Epi::AFTER_DRAIN) { E(acc, cur, wr, wc, fr, fq); S.done(cur); }
        if (!has_next) break;
#pragma unroll
        for (int a = 0; a < 2; ++a)
#pragma unroll
            for (int b = 0; b < 2; ++b)
#pragma unroll
                for (int m = 0; m < 4; ++m)
#pragma unroll
                    for (int n = 0; n < 2; ++n) acc[a][b][m][n] = AccT<I8>::zero();
        cur = nxt; cA = nA; cB = nB; ++ui;
        if constexpr (ALIGN_EPI) { if (wr == 1) PG8_BAR; }
    }
    PG8_WAIT_V(0);
    if constexpr (!ALIGN_EPI) { if (wr == 0) PG8_BAR; }
    PG8_BAR;
    if constexpr (Epi::AFTER_DRAIN) { E.fused(acc, cur, wr, wc, fr, fq, lds, wid, lane); S.done(cur); }
#undef PG8_SA
#undef PG8_SB
#undef PG8_STAGE
#undef PG8_LDA
#undef PG8_LDB
#undef PG8_MMA
#undef PG8_WAIT_V
#undef PG8_WAIT_L
#undef PG8_BAR
#undef PG8_SCHED
}
}

namespace attn {
using bf16 = __hip_bfloat16;
constexpr int   D = 128, NW = 8, QBLK = 32, KVBLK = 64;
constexpr float SCALE = 0.088388347648318440f;
constexpr float THR = 8.f;
constexpr int SDEPTH = 2;
constexpr int LDQ = 2048, LDK = 512, LDG = 24576, LDY = 4096;
constexpr size_t SHM_V = KVBLK * D * 2, SHM_K = KVBLK * D * 2, SHM_ATTN = 2 * SHM_V + 2 * SHM_K + NW * 64 * 4;
using bf16x8 = __attribute__((ext_vector_type(8))) short;
using s16x4  = __attribute__((ext_vector_type(4))) short;
using f32x16 = __attribute__((ext_vector_type(16))) float;
using f32x8  = __attribute__((ext_vector_type(8))) float;
using u32x4  = __attribute__((ext_vector_type(4))) unsigned;
#define KSWZ(row, colB) ((row) * 256 + ((colB) ^ (((row) & 7) << 4)))
#define SBAR() __builtin_amdgcn_sched_barrier(0)
__device__ __forceinline__ int crow(int r, int hi) { return (r & 3) + 8 * (r >> 2) + 4 * hi; }
__device__ __forceinline__ unsigned cvtpk(float lo, float hi) { return pg8::cvt_pk_bf16(lo, hi); }
template <typename TIn> struct Stage;
template <> struct Stage<bf16>  { using T = bf16x8;
  __device__ static __forceinline__ T ld8(const bf16* p) { return *reinterpret_cast<const bf16x8*>(p); }
  __device__ static __forceinline__ bf16x8 tobf(T x) { return x; } };
template <> struct Stage<float> { using T = f32x8;
  __device__ static __forceinline__ T ld8(const float* p) { return *reinterpret_cast<const f32x8*>(p); }
  __device__ static __forceinline__ bf16x8 tobf(T x) {
    u32x4 w = {cvtpk(x[0], x[1]), cvtpk(x[2], x[3]), cvtpk(x[4], x[5]), cvtpk(x[6], x[7])}; return *reinterpret_cast<bf16x8*>(&w); } };

__device__ __forceinline__ void partialSM(f32x16& p0, f32x16& p1, float& m_reg, float& mn, float& alpha) {
  constexpr float C = SCALE * 1.4426950408889634f;
  float pmax = p0[0]; for (int r = 1; r < 16; ++r) pmax = fmaxf(pmax, p0[r]); for (int r = 0; r < 16; ++r) pmax = fmaxf(pmax, p1[r]);
  { auto rr = __builtin_amdgcn_permlane32_swap(__float_as_uint(pmax), __float_as_uint(pmax), false, false);
    pmax = fmaxf(__uint_as_float(rr[0]), __uint_as_float(rr[1])); }
  if (__builtin_expect(__all(pmax - m_reg <= THR / SCALE), 1)) { mn = m_reg; alpha = 1.f; }
  else { mn = fmaxf(m_reg, pmax); alpha = __builtin_amdgcn_exp2f((m_reg - mn) * C); m_reg = mn; }
  float mnC = -mn * C;
  for (int r = 0; r < 16; ++r) p0[r] = fmaf(p0[r], C, mnC); for (int r = 0; r < 16; ++r) p1[r] = fmaf(p1[r], C, mnC);
  for (int r = 0; r < 16; ++r) p0[r] = __builtin_amdgcn_exp2f(p0[r]);
}
__device__ __forceinline__ void finishSM(f32x16& p0, f32x16& p1, float alpha, float& l_reg, bf16x8& pa0, bf16x8& pa1, bf16x8& pa2, bf16x8& pa3) {
  for (int r = 0; r < 16; ++r) p1[r] = __builtin_amdgcn_exp2f(p1[r]);
  float ps = 0; for (int r = 0; r < 16; ++r) ps += p0[r]; for (int r = 0; r < 16; ++r) ps += p1[r];
  { auto rr = __builtin_amdgcn_permlane32_swap(__float_as_uint(ps), __float_as_uint(ps), false, false);
    ps = __uint_as_float(rr[0]) + __uint_as_float(rr[1]); }
  l_reg = l_reg * alpha + ps;
#define PK4(P, BASE, OUT) do { unsigned a0 = cvtpk(P[BASE + 0], P[BASE + 1]), a1 = cvtpk(P[BASE + 2], P[BASE + 3]);   \
    unsigned b0 = cvtpk(P[BASE + 4], P[BASE + 5]), b1 = cvtpk(P[BASE + 6], P[BASE + 7]);                              \
    auto r0 = __builtin_amdgcn_permlane32_swap(a0, b0, false, false); auto r1 = __builtin_amdgcn_permlane32_swap(a1, b1, false, false); \
    u32x4 w = {r0[0], r1[0], r0[1], r1[1]}; OUT = *reinterpret_cast<bf16x8*>(&w); } while (0)
  PK4(p0, 0, pa0); PK4(p0, 8, pa1); PK4(p1, 0, pa2); PK4(p1, 8, pa3);
#undef PK4
}
__device__ __forceinline__ void qkt(f32x16& p0, f32x16& p1, const bf16* Ks, const bf16x8* qr, int r32, int hi) {
  p0 = f32x16{}; p1 = f32x16{};
  for (int d0 = 0; d0 < 8; ++d0) { int cb = (d0 * 16 + hi * 8) * 2;
    bf16x8 b0 = *reinterpret_cast<const bf16x8*>((const char*)Ks + KSWZ(r32, cb));
    bf16x8 b1 = *reinterpret_cast<const bf16x8*>((const char*)Ks + KSWZ(32 + r32, cb));
    p0 = __builtin_amdgcn_mfma_f32_32x32x16_bf16(b0, qr[d0], p0, 0, 0, 0);
    p1 = __builtin_amdgcn_mfma_f32_32x32x16_bf16(b1, qr[d0], p1, 0, 0, 0); }
}
__device__ __forceinline__ int v_st(int k, int c) { const int kk = (k & ~0xC) | ((k & 4) << 1) | ((k & 8) >> 1); return ((kk >> 3) * 4 + (c >> 5)) * 512 + ((kk & 7) * 32 + (c & 31)) * 2; }
__device__ __forceinline__ int v_rd_base(int lane) { return ((lane & 3) << 3) | (((lane >> 2) & 3) << 6) | (((lane >> 4) & 1) << 5) | (((lane >> 5) & 1) << 8); }
constexpr int v_rd_off(int d0, int ks, int half) { return d0 * 512 + ks * 4096 + half * 2048; }
template <int OFF> __device__ __forceinline__ s16x4 tr_read(int vb) {
  s16x4 r; asm volatile("ds_read_b64_tr_b16 %0, %1 offset:%2" : "=&v"(r) : "v"(vb), "i"(OFF) : "memory"); return r;
}
template <int D0> __device__ __forceinline__ void pv_one(f32x16& od, int vb, bf16x8 pa0, bf16x8 pa1, bf16x8 pa2, bf16x8 pa3) {
  const s16x4 l0 = tr_read<v_rd_off(D0, 0, 0)>(vb), h0 = tr_read<v_rd_off(D0, 0, 1)>(vb), l1 = tr_read<v_rd_off(D0, 1, 0)>(vb), h1 = tr_read<v_rd_off(D0, 1, 1)>(vb);
  const s16x4 l2 = tr_read<v_rd_off(D0, 2, 0)>(vb), h2 = tr_read<v_rd_off(D0, 2, 1)>(vb), l3 = tr_read<v_rd_off(D0, 3, 0)>(vb), h3 = tr_read<v_rd_off(D0, 3, 1)>(vb);
  asm volatile("s_waitcnt lgkmcnt(0)" ::: "memory"); SBAR();
#define PK(L, H) (bf16x8){L[0], L[1], L[2], L[3], H[0], H[1], H[2], H[3]}
  od = __builtin_amdgcn_mfma_f32_32x32x16_bf16(pa0, PK(l0, h0), od, 0, 0, 0);
  od = __builtin_amdgcn_mfma_f32_32x32x16_bf16(pa1, PK(l1, h1), od, 0, 0, 0);
  od = __builtin_amdgcn_mfma_f32_32x32x16_bf16(pa2, PK(l2, h2), od, 0, 0, 0);
  od = __builtin_amdgcn_mfma_f32_32x32x16_bf16(pa3, PK(l3, h3), od, 0, 0, 0);
#undef PK
}
__device__ __forceinline__ void pv_d0(f32x16* o, int vb, bf16x8 pa0, bf16x8 pa1, bf16x8 pa2, bf16x8 pa3) {
  pv_one<0>(o[0], vb, pa0, pa1, pa2, pa3); pv_one<1>(o[1], vb, pa0, pa1, pa2, pa3); pv_one<2>(o[2], vb, pa0, pa1, pa2, pa3); pv_one<3>(o[3], vb, pa0, pa1, pa2, pa3);
}
__device__ __forceinline__ void attn_dense_body(const bf16* __restrict__ Qb, const bf16* __restrict__ Kh, const bf16* __restrict__ Vh,
                                                const unsigned short* __restrict__ Gb, unsigned short* __restrict__ Yb, int seq, char* lds, const int tid) {
  using TQ = bf16; using St = Stage<bf16>; using SQ = Stage<TQ>;
  const int wid = tid >> 6, lane = tid & 63, r32 = lane & 31, hi = lane >> 5;
  bf16* V_lds = (bf16*)lds; bf16* K_lds = (bf16*)(lds + 2 * SHM_V);
  float* ws = (float*)(lds + 2 * SHM_V + 2 * SHM_K) + wid * 64; float* li_l = ws; float* al_l = ws + 32;
  float m_reg = -1e30f, l_reg = 0; f32x16 o[4] = {}; bf16x8 qr[8];
  const TQ* Qw = Qb + (long)(wid * QBLK + r32) * LDQ + hi * 8;
#pragma unroll
  for (int d0 = 0; d0 < 8; ++d0) qr[d0] = SQ::tobf(SQ::ld8(Qw + d0 * 16));
  const int sr = tid >> 4, sc = (tid & 15) * 8, vst0 = v_st(sr, sc), vst1 = v_st(32 + sr, sc);
  const int vb0 = (int)(uintptr_t)V_lds + v_rd_base(lane);
  struct { typename St::T vs0, vs1, ks0, ks1; } sr_[SDEPTH];
#define SLOAD(i, k0) do { sr_[i].vs0 = St::ld8(&Vh[(long)((k0) + sr) * LDK + sc]); sr_[i].vs1 = St::ld8(&Vh[(long)((k0) + 32 + sr) * LDK + sc]); \
    sr_[i].ks0 = St::ld8(&Kh[(long)((k0) + sr) * LDK + sc]); sr_[i].ks1 = St::ld8(&Kh[(long)((k0) + 32 + sr) * LDK + sc]); } while (0)
#define SWRITE(b, i) do { *(bf16x8*)((char*)V_lds + (b) * SHM_V + vst0) = St::tobf(sr_[i].vs0);          \
    *(bf16x8*)((char*)V_lds + (b) * SHM_V + vst1) = St::tobf(sr_[i].vs1); int kc = sc * 2;               \
    *(bf16x8*)((char*)K_lds + (b) * SHM_K + KSWZ(sr, kc)) = St::tobf(sr_[i].ks0);                       \
    *(bf16x8*)((char*)K_lds + (b) * SHM_K + KSWZ(32 + sr, kc)) = St::tobf(sr_[i].ks1); } while (0)
#define SWAIT() do { if constexpr (SDEPTH == 2) asm volatile("s_waitcnt vmcnt(4)" ::: "memory"); else asm volatile("s_waitcnt vmcnt(0)" ::: "memory"); } while (0)
#define RESC(a) do { if (__any((a) < 1.f)) { if (hi == 0) al_l[r32] = (a); asm volatile("s_waitcnt lgkmcnt(0)" ::: "memory"); \
    for (int d = 0; d < 4; ++d) for (int r = 0; r < 16; ++r) o[d][r] *= al_l[crow(r, hi)]; } } while (0)
  f32x16 pA0, pA1, pB0, pB1; float mnA, mnB, alA, alB; bf16x8 pa0, pa1, pa2, pa3; const int NT = seq / KVBLK;
  constexpr int SE = 0, SO = SDEPTH - 1;
  SLOAD(SE, 0); asm volatile("s_waitcnt vmcnt(0)" ::: "memory"); SWRITE(0, SE); __syncthreads();
  qkt(pA0, pA1, K_lds, qr, r32, hi); partialSM(pA0, pA1, m_reg, mnA, alA);
  SLOAD(SO, KVBLK); if constexpr (SDEPTH == 2) { if (2 < NT) SLOAD(SE, 2 * KVBLK); }
  SWAIT(); SWRITE(1, SO); __syncthreads();
  for (int j = 1; j + 1 < NT; j += 2) {
    SBAR(); qkt(pB0, pB1, (bf16*)((char*)K_lds + SHM_K), qr, r32, hi);
    finishSM(pA0, pA1, alA, l_reg, pa0, pa1, pa2, pa3); SBAR();
    SLOAD(SO, (j + SDEPTH) * KVBLK); SBAR();
    pv_d0(o, vb0, pa0, pa1, pa2, pa3); partialSM(pB0, pB1, m_reg, mnB, alB);
    __syncthreads(); SWAIT(); SWRITE(0, SE);
    RESC(alB); __syncthreads();
    SBAR(); qkt(pA0, pA1, K_lds, qr, r32, hi);
    finishSM(pB0, pB1, alB, l_reg, pa0, pa1, pa2, pa3); SBAR();
    if (SDEPTH == 1 || j + 3 < NT) SLOAD(SE, (j + 1 + SDEPTH) * KVBLK); SBAR();
    pv_d0(o, vb0 + (int)SHM_V, pa0, pa1, pa2, pa3); partialSM(pA0, pA1, m_reg, mnA, alA);
    __syncthreads(); SWAIT(); SWRITE(1, SO);
    RESC(alA); __syncthreads();
  }
  SBAR(); qkt(pB0, pB1, (bf16*)((char*)K_lds + SHM_K), qr, r32, hi);
  finishSM(pA0, pA1, alA, l_reg, pa0, pa1, pa2, pa3); SBAR();
  pv_d0(o, vb0, pa0, pa1, pa2, pa3); partialSM(pB0, pB1, m_reg, mnB, alB);
  __syncthreads(); RESC(alB);
  finishSM(pB0, pB1, alB, l_reg, pa0, pa1, pa2, pa3); SBAR();
  pv_d0(o, vb0 + (int)SHM_V, pa0, pa1, pa2, pa3);
  if (hi == 0) li_l[r32] = l_reg; asm volatile("s_waitcnt lgkmcnt(0)" ::: "memory");
  float rli[16];
#pragma unroll
  for (int r = 0; r < 16; ++r) rli[r] = __builtin_amdgcn_rcpf(li_l[crow(r, hi)]);
  __syncthreads();
  { typedef __attribute__((address_space(3))) char lds_char; lds_char* ost = (lds_char*)lds + wid * 8192;
    const unsigned stb = (unsigned)(r32 * 2);
#pragma unroll
    for (int r = 0; r < 16; ++r) { const int orow = crow(r, hi);
#pragma unroll
      for (int d0 = 0; d0 < 4; ++d0) { const float v = o[d0][r] * rli[r]; unsigned u = __float_as_uint(v); u = (u + 0x7fffu + ((u >> 16) & 1u)) >> 16;
        *(__attribute__((address_space(3))) unsigned short*)(ost + orow * 256 + ((d0 * 64 + stb) ^ ((orow & 4) << 4))) = (unsigned short)u; } }
    asm volatile("s_waitcnt lgkmcnt(0)" ::: "memory");
    const unsigned short* Gw = Gb + (long)(wid * QBLK) * LDG; unsigned short* Yw = Yb + (long)(wid * QBLK) * LDY;
    const int rsub = lane >> 4, c8 = (lane & 15) * 8;
    u32x4 gv[8];
#pragma unroll
    for (int it = 0; it < 8; ++it) gv[it] = *reinterpret_cast<const u32x4*>(Gw + (long)(it * 4 + rsub) * LDG + c8);
#pragma unroll
    for (int it = 0; it < 8; ++it) { const int row = it * 4 + rsub;
      const u32x4 ov = *(const __attribute__((address_space(3))) u32x4*)(ost + row * 256 + ((c8 * 2) ^ ((row & 4) << 4)));
      u32x4 w;
#pragma unroll
      for (int q = 0; q < 4; ++q) { const unsigned oo = ov[q], gg = gv[it][q];
        const float o_lo = __uint_as_float(oo << 16), o_hi = __uint_as_float(oo & 0xffff0000u), g_lo = __uint_as_float(gg << 16), g_hi = __uint_as_float(gg & 0xffff0000u);
        const float y_lo = o_lo * g_lo * __builtin_amdgcn_rcpf(1.0f + __expf(-g_lo)), y_hi = o_hi * g_hi * __builtin_amdgcn_rcpf(1.0f + __expf(-g_hi));
        w[q] = cvtpk(y_lo, y_hi); }
      *reinterpret_cast<u32x4*>(Yw + (long)row * LDY + c8) = w; } }
  __syncthreads();
#undef SLOAD
#undef SWRITE
#undef SWAIT
#undef RESC
}
}

constexpr int NWAVES = 8;
constexpr int RING_OFF = 0, RING_BYTES = 131072;
constexpr int LDSCTL_OFF = RING_BYTES, MISC_OFF = LDSCTL_OFF + 320;
constexpr int LDS_BYTES = 147456;

#define GAS __attribute__((address_space(1)))
#define LAS __attribute__((address_space(3)))
typedef unsigned short bf16;
typedef unsigned v4u __attribute__((ext_vector_type(4)));
typedef unsigned v2u __attribute__((ext_vector_type(2)));
typedef float f32x4 __attribute__((ext_vector_type(4)));
typedef short bf16x8 __attribute__((ext_vector_type(8)));
typedef GAS unsigned gu32;
#define RLX_AGENT __ATOMIC_RELAXED, __HIP_MEMORY_SCOPE_AGENT
#define LDS_WAIT() asm volatile("s_waitcnt lgkmcnt(0)" ::: "memory")
#define VM_WAIT() asm volatile("s_waitcnt vmcnt(0)" ::: "memory")
__device__ __forceinline__ unsigned f2bf(float f) { unsigned u = __builtin_bit_cast(unsigned, f); return (u + 0x7fffu + ((u >> 16) & 1u)) >> 16; }
__device__ __forceinline__ unsigned pk2(float lo, float hi) { return pg8::cvt_pk_bf16(lo, hi); }
__device__ __forceinline__ float bflo(unsigned w) { return __uint_as_float(w << 16); }
__device__ __forceinline__ float bfhi(unsigned w) { return __uint_as_float(w & 0xffff0000u); }
__device__ __forceinline__ float silu_f(float x) { return x * __builtin_amdgcn_rcpf(1.0f + __expf(-x)); }
__device__ __forceinline__ void unpack8(v4u w, float (&f)[8]) { f[0] = bflo(w.x); f[1] = bfhi(w.x); f[2] = bflo(w.y); f[3] = bfhi(w.y); f[4] = bflo(w.z); f[5] = bfhi(w.z); f[6] = bflo(w.w); f[7] = bfhi(w.w); }
__device__ __forceinline__ v4u pack8(const float (&f)[8]) { v4u w; w.x = pk2(f[0], f[1]); w.y = pk2(f[2], f[3]); w.z = pk2(f[4], f[5]); w.w = pk2(f[6], f[7]); return w; }
__device__ __forceinline__ float wave_sum(float v) {
#pragma unroll
    for (int o = 1; o < 64; o <<= 1) v += __shfl_xor(v, o);
    return v;
}

template <int CTRL> __device__ __forceinline__ float dpp_f(float v) { return __builtin_bit_cast(float, __builtin_amdgcn_update_dpp(0, __builtin_bit_cast(int, v), CTRL, 0xF, 0xF, true)); }
__device__ __forceinline__ float sum16(float v) {
    v += dpp_f<0xB1>(v); v += dpp_f<0x4E>(v); v += dpp_f<0x141>(v); v += dpp_f<0x140>(v); return v; }
__device__ __forceinline__ float lane_xor4(float v) {
    const int s = __builtin_bit_cast(int, v);
    int t = __builtin_amdgcn_update_dpp(0, s, 0x104, 0xF, 0x5, false);
    t = __builtin_amdgcn_update_dpp(t, s, 0x114, 0xF, 0xA, false);
    return __builtin_bit_cast(float, t); }

#define XB_TMO      128
#define XB_XCNT(j)  (256  + 64 * (j))
#define XB_XSUB(j)  (1280 + 64 * (j))
#define XB_XGEN(j)  (2304 + 64 * (j))
#define XB_TOP      3328
#define XB_TOPGEN   3392
#define XCD_BAR_WORDS 3456
#define XB_SPIN_CAP (1u << 18)

__device__ __forceinline__ unsigned xb_ld(unsigned* p)              { return __hip_atomic_load(p, __ATOMIC_RELAXED, __HIP_MEMORY_SCOPE_AGENT); }
__device__ __forceinline__ unsigned xb_add(unsigned* p, unsigned v) { return __hip_atomic_fetch_add(p, v, __ATOMIC_RELAXED, __HIP_MEMORY_SCOPE_AGENT); }
__device__ __forceinline__ unsigned xb_xcc_id() { return (unsigned)__builtin_amdgcn_s_getreg((3 << 11) | 20) & 0xFu; }
#define XB_SPIN(cond, bar) do { unsigned _sp = 0; while (cond) { __builtin_amdgcn_s_sleep(1); \
    if ((++_sp & 255u) == 0u) { if (xb_ld(&(bar)[XB_TMO])) break; if (_sp > XB_SPIN_CAP) { atomicAdd(&(bar)[XB_TMO], 1u); break; } } } } while (0)

struct XcdBarrier {
    unsigned* bar; unsigned x;
    volatile LAS unsigned* st;
};

__device__ __forceinline__ XcdBarrier xcd_barrier_post(unsigned* bar, volatile LAS unsigned* st) {
    XcdBarrier b; b.bar = bar; b.x = xb_xcc_id(); b.st = st;
    if (threadIdx.x == 0) (void)xb_add(&bar[XB_XCNT(b.x)], 1u);
    return b;
}
__device__ __forceinline__ void xcd_barrier_complete(unsigned* bar, unsigned x, unsigned& nloc, unsigned& nx) {
    const unsigned G = gridDim.x * gridDim.y * gridDim.z;
    unsigned sum, cnt, mine, sp = 0u;
    for (;;) {
        sum = 0u; cnt = 0u; mine = 0u;
#pragma unroll
        for (unsigned j = 0; j < 16; ++j) { const unsigned c = xb_ld(&bar[XB_XCNT(j)]); sum += c; cnt += (c > 0u) ? 1u : 0u; mine = (j == x) ? c : mine; }
        if (sum == G) break;
        __builtin_amdgcn_s_sleep(1);
        if ((++sp & 255u) == 0u) { if (xb_ld(&bar[XB_TMO])) break; if (sp > XB_SPIN_CAP) { atomicAdd(&bar[XB_TMO], 1u); break; } }
    }
    nloc = mine > 0u ? mine : 1u; nx = cnt > 0u ? cnt : 1u;
}

__device__ __forceinline__ void xcd_barrier(const XcdBarrier& b, const bool t0) {
    asm volatile("s_waitcnt vmcnt(0)" ::: "memory");
    __syncthreads();
    if (t0) {
        unsigned* bar = b.bar;
        __builtin_amdgcn_s_waitcnt(0);
        unsigned nloc = b.st[0], nx = b.st[1];
        if (nloc == 0u) { xcd_barrier_complete(bar, b.x, nloc, nx); b.st[0] = nloc; b.st[1] = nx; }
        const unsigned old = xb_add(&bar[XB_XSUB(b.x)], 1u);
        const unsigned gen = old / nloc;
        if (old + 1u == (gen + 1u) * nloc) {
            __builtin_amdgcn_fence(__ATOMIC_RELEASE, "agent");
            asm volatile("s_waitcnt vmcnt(0)" ::: "memory");
            const unsigned og = xb_add(&bar[XB_TOP], 1u);
            const unsigned tg = og / nx;
            if (og + 1u == (tg + 1u) * nx) xb_add(&bar[XB_TOPGEN], 1u);
            else XB_SPIN(xb_ld(&bar[XB_TOPGEN]) == tg, bar);
            __builtin_amdgcn_fence(__ATOMIC_ACQUIRE, "agent");
            xb_add(&bar[XB_XGEN(b.x)], 1u);
            asm volatile("s_waitcnt vmcnt(0)" ::: "memory");
        } else {
            XB_SPIN(xb_ld(&bar[XB_XGEN(b.x)]) == gen, bar);
            __builtin_amdgcn_fence(__ATOMIC_ACQUIRE, "agent");
            asm volatile("s_waitcnt vmcnt(0)" ::: "memory");
        }
    }
    __syncthreads();
}

__device__ __forceinline__ void p0_transpose_item(const float* W, int K, int N, bf16* WT, int item, int lane, float* cmax = nullptr, int cmode = 1, int ldw = 0, int koff = 0) {
    const int nblk = N / 64, kbk = item / nblk, nb = item % nblk, k0 = 64 * kbk + 8 * (lane >> 3), n0 = 64 * nb + 4 * (lane & 7);
    f32x4 v[2][8];
#pragma unroll
    for (int h = 0; h < 2; ++h)
#pragma unroll
        for (int e = 0; e < 8; ++e) v[h][e] = __builtin_nontemporal_load((const f32x4*)(W + (size_t)(k0 + e) * N + n0 + 32 * h));
#pragma unroll
    for (int h = 0; h < 2; ++h)
#pragma unroll
        for (int j = 0; j < 4; ++j) { v4u o; o.x = pk2(v[h][0][j], v[h][1][j]); o.y = pk2(v[h][2][j], v[h][3][j]); o.z = pk2(v[h][4][j], v[h][5][j]); o.w = pk2(v[h][6][j], v[h][7][j]);
            *(v4u*)(WT + (size_t)(n0 + 32 * h + j) * (ldw ? ldw : K) + koff + k0) = o; }
    if (cmax && (cmode == 2 || n0 < C_BF0 || n0 >= C_BF1)) { const int q0 = (cmode == 2 || n0 < C_BF0) ? n0 : n0 - (C_BF1 - C_BF0); const int cpitch = cmode == 2 ? DM : NI8;
#pragma unroll
        for (int h = 0; h < 2; ++h) { f32x4 mx4;
#pragma unroll
            for (int j = 0; j < 4; ++j) { float mx = 0.f;
#pragma unroll
                for (int e = 0; e < 8; ++e) mx = fmaxf(mx, fabsf(v[h][e][j]));
                mx = fmaxf(mx, __shfl_xor(mx, 8)); mx = fmaxf(mx, __shfl_xor(mx, 16)); mx = fmaxf(mx, __shfl_xor(mx, 32)); mx4[j] = mx; }
            if (lane < 8) *(f32x4*)(cmax + (size_t)kbk * cpitch + q0 + 32 * h) = mx4; }
    }
}
__device__ __forceinline__ void sincos_d(double a, float& c, float& s) {
    const double k = __builtin_rint(a * 0.15915494309189535);
    double r = __builtin_fma(-k, 6.283185307179586, a); r = __builtin_fma(-k, 2.4492935982947064e-16, r);
    const double r2 = r * r;
    double q = -r2;
    double sn = 3.8681701706306835e-23;
    sn = sn * q + 1.9572941063391263e-20; sn = sn * q + 8.22063524662433e-18; sn = sn * q + 2.8114572543455206e-15; sn = sn * q + 7.647163731819816e-13;
    sn = sn * q + 1.6059043836821613e-10; sn = sn * q + 2.505210838544172e-08; sn = sn * q + 2.7557319223985893e-06; sn = sn * q + 0.0001984126984126984;
    sn = sn * q + 0.008333333333333333; sn = sn * q + 0.16666666666666666; sn = sn * q + 1.0; sn = sn * r;
    double cs = 1.6117375710961184e-24;
    cs = cs * q + 8.896791392450574e-22; cs = cs * q + 4.110317623312165e-19; cs = cs * q + 1.5619206968586225e-16; cs = cs * q + 4.779477332387385e-14;
    cs = cs * q + 1.1470745597729725e-11; cs = cs * q + 2.08767569878681e-09; cs = cs * q + 2.755731922398589e-07; cs = cs * q + 2.48015873015873e-05;
    cs = cs * q + 0.001388888888888889; cs = cs * q + 0.041666666666666664; cs = cs * q + 0.5; cs = cs * q + 1.0;
    c = (float)cs; s = (float)sn;
}
__device__ __forceinline__ v4u norm_rope8(v4u in, const float* gain8, bool rope, int hl, int pos0, int pos1, const float* cosT, const float* sinT) {
    float f[8]; unpack8(in, f);
    float ss = 0.f;
#pragma unroll
    for (int e = 0; e < 8; ++e) ss += f[e] * f[e];
    ss += __shfl_xor(ss, 1); ss += __shfl_xor(ss, 2); ss += __shfl_xor(ss, 4); ss += __shfl_xor(ss, 8);
    const float rstd = 1.0f / sqrtf(ss * (1.0f / 128.0f) + EPS);
    const f32x4 g0 = *(const f32x4*)gain8, g1 = *(const f32x4*)(gain8 + 4);
    float y[8];
#pragma unroll
    for (int e = 0; e < 4; ++e) { y[e] = f[e] * rstd * g0[e]; y[4 + e] = f[4 + e] * rstd * g1[e]; }
    if (rope) {
        const int pos = (hl >> 3) ? pos1 : pos0, j0 = (hl & 3) * 8; const bool first = (hl & 7) < 4;
        const f32x4 c0 = *(const f32x4*)(cosT + pos * 32 + j0), c1 = *(const f32x4*)(cosT + pos * 32 + j0 + 4);
        const f32x4 s0 = *(const f32x4*)(sinT + pos * 32 + j0), s1 = *(const f32x4*)(sinT + pos * 32 + j0 + 4);
#pragma unroll
        for (int e = 0; e < 8; ++e) { const float py = __shfl_xor(y[e], 4); const float cs = e < 4 ? c0[e & 3] : c1[e & 3], sn = e < 4 ? s0[e & 3] : s1[e & 3];
            y[e] = first ? (y[e] * cs - py * sn) : (y[e] * cs + py * sn); }
    }
    return pack8(y);
}

struct Args { const float* in[20]; float* out; unsigned char* ws; };
typedef const Args __attribute__((address_space(4))) * ArgsP;
struct Ctx { int tid, lane, wave, gw, NGW, G, bx, vcu; ArgsP ap; unsigned char* ws; };
__device__ __forceinline__ int lane_id_fresh() { int ln; asm volatile("v_mbcnt_lo_u32_b32 %0, -1, 0\n\tv_mbcnt_hi_u32_b32 %0, -1, %0" : "=v"(ln)); return ln; }
__device__ __forceinline__ Ctx fresh_ctx(int wv) {
    Ctx c; int t = wv * 64 + lane_id_fresh(); c.tid = t; c.lane = t & 63; c.wave = wv;
    int G = gridDim.x, bx = blockIdx.x; asm volatile("" : "+s"(G), "+s"(bx));
    c.G = G; c.bx = bx; c.vcu = (G % 8 == 0) ? (bx % 8) * (G / 8) + bx / 8 : bx;
    c.gw = c.vcu * NWAVES + c.wave; c.NGW = G * NWAVES;
    ArgsP ap = (ArgsP)__builtin_amdgcn_kernarg_segment_ptr(); asm volatile("" : "+s"(ap)); c.ap = ap; c.ws = ap->ws;
    return c;
}

__device__ __forceinline__ void weight_transposes(const Ctx& c, int l, int it0, int it1, int w, int nw) {
    unsigned char* ws = c.ws; const int lane = c.lane;
    const float* w_in = c.ap->in[6]; const float* w_br_attn = c.ap->in[14]; const float* w_br_conv = c.ap->in[15]; const float* w_br_gm = c.ap->in[16]; const float* w_out = c.ap->in[17];
    for (int it = it0 + w; it < it1; it += nw) {
        int r = it;
        if (r < 24576) { p0_transpose_item(w_in + (size_t)l * DM * INC, DM, INC, (bf16*)(ws + WS_WIN + l * WIN_L), r, lane, (float*)(ws + WS_PMAX) + (size_t)l * 64 * NI8); continue; } r -= 24576;
        if (r < 2048) { p0_transpose_item(w_br_attn + (size_t)l * ATTN_W * DM, ATTN_W, DM, (bf16*)(ws + WS_WBR + l * WBR_L), r, lane, nullptr, 1, DM, 0); continue; } r -= 2048;
        if (r < 1024) { p0_transpose_item(w_br_conv + (size_t)l * CONV_W * DM, CONV_W, DM, (bf16*)(ws + WS_WBR + l * WBR_L), r, lane, nullptr, 1, DM, ATTN_W); continue; } r -= 1024;
        if (r < 1024) { p0_transpose_item(w_br_gm + (size_t)l * GM_W * DM, GM_W, DM, (bf16*)(ws + WS_WBR + l * WBR_L), r, lane, nullptr, 1, DM, ATTN_W + CONV_W); continue; } r -= 1024;
        p0_transpose_item(w_out + (size_t)l * DM * DM, DM, DM, (bf16*)(ws + WS_WOUT + l * WOUT_L), r, lane, (float*)(ws + WS_PMAXO) + (size_t)l * 64 * DM, 2);
    }
}
__device__ __forceinline__ float wave_max(float v) {
    v = fmaxf(v, dpp_f<0xB1>(v)); v = fmaxf(v, dpp_f<0x4E>(v)); v = fmaxf(v, dpp_f<0x141>(v)); v = fmaxf(v, dpp_f<0x140>(v));
    const float a = __builtin_bit_cast(float, __builtin_amdgcn_readlane(__builtin_bit_cast(int, v), 0)), b = __builtin_bit_cast(float, __builtin_amdgcn_readlane(__builtin_bit_cast(int, v), 16));
    const float cc = __builtin_bit_cast(float, __builtin_amdgcn_readlane(__builtin_bit_cast(int, v), 32)), d = __builtin_bit_cast(float, __builtin_amdgcn_readlane(__builtin_bit_cast(int, v), 48));
    return fmaxf(fmaxf(a, b), fmaxf(cc, d)); }
struct QRow { const float* pm; float* swp; const bf16* src; unsigned char* dst; };
__device__ __forceinline__ QRow qrow(const Ctx& c, int l, int nn) {
    const bool wo = nn >= NI8; const int n = wo ? nn - NI8 : nn, col = wo ? n : (n < C_BF0 ? n : n + (C_BF1 - C_BF0));
    QRow r;
    r.pm = wo ? (const float*)(c.ws + WS_PMAXO) + ((size_t)l * 64 + c.lane) * DM + n : (const float*)(c.ws + WS_PMAX) + ((size_t)l * 64 + c.lane) * NI8 + n;
    r.swp = wo ? (float*)(c.ws + WS_SWO) + l * DM + n : (float*)(c.ws + WS_SW) + l * NI8 + n;
    r.src = (wo ? (const bf16*)(c.ws + WS_WOUT + l * WOUT_L) : (const bf16*)(c.ws + WS_WIN + l * WIN_L)) + (size_t)col * DM;
    r.dst = (wo ? c.ws + WS_W8O + l * W8O_L : c.ws + WS_W8 + l * W8_L) + (size_t)n * DM;
    return r; }
__device__ __forceinline__ void quantize_w8(const Ctx& c, int l, int nn0, int nn1) {
#pragma unroll 1
    for (int nnA = nn0 + c.gw; nnA < nn1; nnA += 2 * c.NGW) {
        const bool hasB = nnA + c.NGW < nn1;
        const QRow ra = qrow(c, l, nnA), rb = qrow(c, l, hasB ? nnA + c.NGW : nnA);
        float mxa = *ra.pm, mxb = *rb.pm;
        v4u ia[8], ib[8];
#pragma unroll
        for (int j = 0; j < 8; ++j) { ia[j] = *(const v4u*)(ra.src + j * 512 + c.lane * 8); ib[j] = *(const v4u*)(rb.src + j * 512 + c.lane * 8); }
        mxa = wave_max(mxa); mxb = wave_max(mxb);
        const float sca = mxa > 0.f ? mxa * (1.0f / 127.0f) : 1.0f, inva = 1.0f / sca, scb = mxb > 0.f ? mxb * (1.0f / 127.0f) : 1.0f, invb = 1.0f / scb;
        if (c.lane == 0) { __hip_atomic_store(ra.swp, sca, __ATOMIC_RELAXED, __HIP_MEMORY_SCOPE_AGENT);
            if (hasB) __hip_atomic_store(rb.swp, scb, __ATOMIC_RELAXED, __HIP_MEMORY_SCOPE_AGENT); }
#pragma unroll
        for (int h = 0; h < 2; ++h) { if (h == 1 && !hasB) break;
#pragma unroll
            for (int j = 0; j < 8; ++j) { float f[8]; unpack8(h ? ib[j] : ia[j], f); int q[8]; const float inv = h ? invb : inva;
#pragma unroll
                for (int e = 0; e < 8; ++e) q[e] = __float2int_rn(f[e] * inv);
                v2u w; w.x = (unsigned)(q[0] & 255) | ((unsigned)(q[1] & 255) << 8) | ((unsigned)(q[2] & 255) << 16) | ((unsigned)(q[3] & 255) << 24);
                w.y = (unsigned)(q[4] & 255) | ((unsigned)(q[5] & 255) << 8) | ((unsigned)(q[6] & 255) << 16) | ((unsigned)(q[7] & 255) << 24);
                *(v2u*)((h ? rb.dst : ra.dst) + j * 512 + c.lane * 8) = w; } }
    }
}
__device__ __forceinline__ void modp_items(const Ctx& c, int l, int w, int nw) {
    const float* c_in = c.ap->in[1]; const float* cctx_in = c.ap->in[3]; const float* w_ada = c.ap->in[4];
    float* modp = (float*)(c.ws + WS_MODP); const int lane = c.lane;
    for (int r = w; r < NKC * 48; r += nw) {
        const int kc = r / 48, cb = r % 48;
        const float* W = w_ada + ((size_t)l * DM + kc * 64) * 12288 + cb * 256 + lane * 4;
        f32x4 a0 = {0.f, 0.f, 0.f, 0.f}, a1 = a0, a2 = a0;
        const int cvi0 = __builtin_bit_cast(int, silu_f(c_in[kc * 64 + lane])), cvi1 = __builtin_bit_cast(int, silu_f(c_in[DM + kc * 64 + lane])), cvi2 = __builtin_bit_cast(int, silu_f(cctx_in[kc * 64 + lane]));
#pragma unroll 1
        for (int k0 = 0; k0 < 64; k0 += 16) { f32x4 wv[16];
#pragma unroll
            for (int j = 0; j < 16; ++j) wv[j] = __builtin_nontemporal_load((const f32x4*)(W + (size_t)(k0 + j) * 12288));
#pragma unroll
            for (int j = 0; j < 16; ++j) { const float s0 = __builtin_bit_cast(float, __builtin_amdgcn_readlane(cvi0, k0 + j)), s1 = __builtin_bit_cast(float, __builtin_amdgcn_readlane(cvi1, k0 + j)), s2 = __builtin_bit_cast(float, __builtin_amdgcn_readlane(cvi2, k0 + j));
                a0 += wv[j] * s0; a1 += wv[j] * s1; a2 += wv[j] * s2; } }
        float* o = modp + ((size_t)(l * NKC + kc) * 3) * 12288 + cb * 256 + lane * 4;
        *(f32x4*)o = a0; *(f32x4*)(o + 12288) = a1; *(f32x4*)(o + 2 * 12288) = a2;
    }
}
__device__ __forceinline__ void modv_reduce(const Ctx& c, int l) {
    const float* b_ada = c.ap->in[5]; float* modv = (float*)(c.ws + WS_MOD); const float* modp = (const float*)(c.ws + WS_MODP);
    for (int r = c.gw * 64 + c.lane; r < 3 * 12288; r += c.NGW * 64) { const int w = r / 12288, col = r % 12288;
        const float* mp = modp + ((size_t)(l * NKC) * 3 + w) * 12288 + col;
        float s = b_ada[l * 12288 + col];
#pragma unroll
        for (int h = 0; h < NKC / 32; ++h) { float v[32];
#pragma unroll
            for (int k = 0; k < 32; ++k) v[k] = mp[(size_t)(h * 32 + k) * 3 * 12288];
#pragma unroll
            for (int k = 0; k < 32; ++k) s += v[k]; }
        modv[l * 36864 + r] = s; }
}
__device__ __forceinline__ void direct_w8_block(const Ctx& c, LAS unsigned char* lds, const float* Wsrc, const int INC_, int srccol, unsigned char* dstrow, float* swdst) {
    const int lane = c.lane, wave = c.wave, kr = lane >> 3, nc = lane & 7;
    const float* W = Wsrc + (size_t)(512 * wave + 8 * kr) * INC_ + srccol + 4 * nc;
    LAS float* pm = (LAS float*)(lds + RING_BYTES + 2048);
    LAS unsigned char* hl = lds + RING_OFF + wave * 16384 + lane * 16;
    f32x4 mx = {0.f, 0.f, 0.f, 0.f};
    unsigned held[4][4][4];
#pragma unroll
    for (int t = 0; t < 8; ++t) { f32x4 v[8]; const float* Wt = W + (size_t)(t * 64) * INC_; asm volatile("" : "+v"(Wt));
#pragma unroll
        for (int e = 0; e < 8; ++e) v[e] = __builtin_nontemporal_load((const f32x4*)(Wt + (size_t)e * INC_));
#pragma unroll
        for (int j = 0; j < 4; ++j) {
#pragma unroll
            for (int e = 0; e < 8; ++e) mx[j] = fmaxf(mx[j], fabsf(v[e][j]));
            v4u pk; pk.x = pk2(v[0][j], v[1][j]); pk.y = pk2(v[2][j], v[3][j]); pk.z = pk2(v[4][j], v[5][j]); pk.w = pk2(v[6][j], v[7][j]);
            if (t < 4) { held[t & 3][j][0] = pk.x; held[t & 3][j][1] = pk.y; held[t & 3][j][2] = pk.z; held[t & 3][j][3] = pk.w; }
            else *(LAS v4u*)(hl + ((t - 4) * 4 + j) * 1024) = pk; }
        if ((t & 3) == 3) { asm volatile("" ::: "memory"); __builtin_amdgcn_sched_barrier(0); } }
#pragma unroll
    for (int j = 0; j < 4; ++j) { float m = mx[j]; m = fmaxf(m, __shfl_xor(m, 8)); m = fmaxf(m, __shfl_xor(m, 16)); m = fmaxf(m, __shfl_xor(m, 32)); mx[j] = m; }
    if (kr == 0) *(LAS f32x4*)(pm + wave * 32 + 4 * nc) = mx;
    __syncthreads();
    f32x4 cm = *(const LAS f32x4*)(pm + 4 * nc);
#pragma unroll
    for (int w2 = 1; w2 < 8; ++w2) { const f32x4 o = *(const LAS f32x4*)(pm + w2 * 32 + 4 * nc);
#pragma unroll
        for (int j = 0; j < 4; ++j) cm[j] = fmaxf(cm[j], o[j]); }
    __syncthreads();
    f32x4 sc, inv;
#pragma unroll
    for (int j = 0; j < 4; ++j) { sc[j] = cm[j] > 0.f ? cm[j] * (1.0f / 127.0f) : 1.0f; inv[j] = 1.0f / sc[j]; }
    if (wave == 0 && kr == 0) *(f32x4*)(swdst + 4 * nc) = sc;
    unsigned char* dst = dstrow + (size_t)(4 * nc) * DM + 512 * wave + 8 * kr;
#pragma unroll
    for (int t = 0; t < 8; ++t) { unsigned char* dt = dst + t * 64; asm volatile("" : "+v"(dt));
#pragma unroll
        for (int j = 0; j < 4; ++j) { v4u pk;
            if (t < 4) { pk.x = held[t & 3][j][0]; pk.y = held[t & 3][j][1]; pk.z = held[t & 3][j][2]; pk.w = held[t & 3][j][3]; }
            else pk = *(const LAS v4u*)(hl + ((t - 4) * 4 + j) * 1024);
            int qi[8];
#pragma unroll
            for (int pr = 0; pr < 4; ++pr) { qi[2 * pr] = __float2int_rn(bflo(pk[pr]) * inv[j]); qi[2 * pr + 1] = __float2int_rn(bfhi(pk[pr]) * inv[j]); }
            v2u w; w.x = (unsigned)(qi[0] & 255) | ((unsigned)(qi[1] & 255) << 8) | ((unsigned)(qi[2] & 255) << 16) | ((unsigned)(qi[3] & 255) << 24);
            w.y = (unsigned)(qi[4] & 255) | ((unsigned)(qi[5] & 255) << 8) | ((unsigned)(qi[6] & 255) << 16) | ((unsigned)(qi[7] & 255) << 24);
            *(v2u*)(dt + (size_t)j * DM) = w; } }
}
__device__ __forceinline__ void direct_win_block(const Ctx& c, LAS unsigned char* lds, int l, int cb) {
    const int n8 = 32 * cb; direct_w8_block(c, lds, c.ap->in[6] + (size_t)l * DM * INC, INC, n8 < C_BF0 ? n8 : n8 + (C_BF1 - C_BF0), c.ws + WS_W8 + l * W8_L + (size_t)n8 * DM, (float*)(c.ws + WS_SW) + l * NI8 + n8); }
__device__ __forceinline__ void direct_wout_block(const Ctx& c, LAS unsigned char* lds, int l, int cb) {
    const int n8 = 32 * cb; direct_w8_block(c, lds, c.ap->in[17] + (size_t)l * DM * DM, DM, n8, c.ws + WS_W8O + l * W8O_L + (size_t)n8 * DM, (float*)(c.ws + WS_SWO) + l * DM + n8); }
__device__ __forceinline__ void bf16_tiles(const Ctx& c, int l, int j0, int j1, int w, int nw) {
    unsigned char* ws = c.ws; const int lane = c.lane; constexpr int NBT = (C_BF1 - C_BF0) / 64;
#pragma unroll 1
    for (int j = j0 + w; j < j1; j += nw) {
        if (j < 64 * NBT) { p0_transpose_item(c.ap->in[6] + (size_t)l * DM * INC, DM, INC, (bf16*)(ws + WS_WIN + l * WIN_L), (j / NBT) * (INC / 64) + C_BF0 / 64 + j % NBT, lane, nullptr); continue; }
        int r = j - 64 * NBT;
        if (r < 2048) { p0_transpose_item(c.ap->in[14] + (size_t)l * ATTN_W * DM, ATTN_W, DM, (bf16*)(ws + WS_WBR + l * WBR_L), r, lane, nullptr, 1, DM, 0); continue; } r -= 2048;
        if (r < 1024) { p0_transpose_item(c.ap->in[15] + (size_t)l * CONV_W * DM, CONV_W, DM, (bf16*)(ws + WS_WBR + l * WBR_L), r, lane, nullptr, 1, DM, ATTN_W); continue; } r -= 1024;
        p0_transpose_item(c.ap->in[16] + (size_t)l * GM_W * DM, GM_W, DM, (bf16*)(ws + WS_WBR + l * WBR_L), r, lane, nullptr, 1, DM, ATTN_W + CONV_W);
    }
}
__device__ __forceinline__ void phase_tail_transposes(LAS unsigned char* lds, int part, int wv) {
    const Ctx c = fresh_ctx(wv);
    constexpr int NB1 = NI8 / 32, NBO = DM / 32, NT0 = 128;
    if (part == 0) {
        if (c.G != 256) { bf16_tiles(c, 0, 7168, 11264, c.gw, c.NGW); for (int cb = c.vcu; cb < NT0; cb += c.G) direct_win_block(c, lds, 1, cb); return; }
        if (c.vcu < 192) return;
        bf16_tiles(c, 0, 7168, 11264, (c.vcu - 192) * NWAVES + c.wave, 64 * NWAVES);
        for (int cb = c.vcu - 192; cb < NT0; cb += 64) direct_win_block(c, lds, 1, cb);
        return; }
    const int nbusy = (34 * 16) % c.G;
    if (c.vcu < nbusy) return;
    const int idx = c.vcu - nbusy, nidle = c.G - nbusy, w = idx * NWAVES + c.wave, nw = nidle * NWAVES;
    if (part == 1) {
        for (int cb = idx; cb < NBO; cb += nidle) direct_wout_block(c, lds, 0, cb);
        modp_items(c, 1, w, nw);
        const int rot = nidle > NBO ? nidle - NBO : 0;
        for (int k = (idx + rot) % nidle; k < NB1 - NT0; k += nidle) direct_win_block(c, lds, 1, NT0 + k); }
    else {
        for (int cb = idx; cb < NBO; cb += nidle) direct_wout_block(c, lds, 1, cb);
        bf16_tiles(c, 1, 0, 11264, w, nw); }
}
__device__ __forceinline__ void phase_p0(LAS unsigned char* lds, int wv) {
    const Ctx c = fresh_ctx(wv); unsigned char* ws = c.ws; const int lane = c.lane;
    constexpr int NBLK = NI8 / 32;
    for (int cb = c.vcu; cb < NBLK; cb += c.G) direct_win_block(c, lds, 0, cb);
    const int nx = (NBLK > 2 * c.G && NBLK < 3 * c.G) ? NBLK - 2 * c.G : 0;
    if (c.vcu >= nx) { const int w = (c.vcu - nx) * NWAVES + c.wave, nw = (c.G - nx) * NWAVES;
        bf16_tiles(c, 0, 0, 64 * ((C_BF1 - C_BF0) / 64), w, nw);
        modp_items(c, 0, w, nw); }
    float* cosT = (float*)(ws + WS_ROPE); float* sinT = cosT + 2048;
    for (int i = c.gw * 64 + lane; i < 2048; i += c.NGW * 64) { const int pos = i >> 5, j = i & 31;
        double f = 1.0; for (int q = 0; q < j; ++q) f *= 0.7498942093324558273;
        float cs, sn; sincos_d((double)pos * f, cs, sn); cosT[i] = cs; sinT[i] = sn; }
}
__device__ __forceinline__ void phase_p1(int wv) {
    const Ctx c = fresh_ctx(wv);
    modv_reduce(c, 0);
}
__device__ __forceinline__ void store_u_row(const f32x4 (&u)[16], int row, int lane, bf16* Ub, unsigned char* U8, float* su) {
    float mx = 0.f;
#pragma unroll
    for (int j = 0; j < 16; ++j) { mx = fmaxf(mx, fmaxf(fmaxf(fabsf(u[j][0]), fabsf(u[j][1])), fmaxf(fabsf(u[j][2]), fabsf(u[j][3]))));
        v2u w; w.x = pk2(u[j][0], u[j][1]); w.y = pk2(u[j][2], u[j][3]); *(v2u*)(Ub + (size_t)row * DM + lane * 4 + 256 * j) = w; }
#pragma unroll
    for (int o = 1; o < 64; o <<= 1) mx = fmaxf(mx, __shfl_xor(mx, o));
    const float sc = mx > 0.f ? mx * (1.0f / 127.0f) : 1.0f, inv = 1.0f / sc;
    if (lane == 0) __hip_atomic_store(su + row, sc, __ATOMIC_RELAXED, __HIP_MEMORY_SCOPE_AGENT);
#pragma unroll
    for (int j = 0; j < 16; ++j) { const int q0 = __float2int_rn(u[j][0] * inv), q1 = __float2int_rn(u[j][1] * inv), q2 = __float2int_rn(u[j][2] * inv), q3 = __float2int_rn(u[j][3] * inv);
        *(unsigned*)(U8 + (size_t)row * DM + lane * 4 + 256 * j) = (unsigned)(q0 & 255) | ((unsigned)(q1 & 255) << 8) | ((unsigned)(q2 & 255) << 16) | ((unsigned)(q3 & 255) << 24); }
}
__device__ __forceinline__ void phase_p2(int wv) {
    const Ctx c = fresh_ctx(wv); const float* x_in = c.ap->in[0]; const float* ctx_in = c.ap->in[2];
    const float* modv = (const float*)(c.ws + WS_MOD); bf16* Ub = (bf16*)(c.ws + WS_U); const int lane = c.lane;
#pragma unroll 2
    for (int row = c.gw; row < MT; row += c.NGW) {
        const float* src = row < NLAT ? x_in + (size_t)row * DM : ctx_in + (size_t)(row - NLAT) * DM;
        const float* mr = modv + (row < SEQ ? 0 : (row < NLAT ? 1 : 2)) * 12288;
        f32x4 u[16];
#pragma unroll
        for (int j = 0; j < 16; ++j) { const int col = lane * 4 + 256 * j;
            const f32x4 xv = *(const f32x4*)(src + col), sh = *(const f32x4*)(mr + col), sc = *(const f32x4*)(mr + DM + col);
            u[j] = xv * (sc + 1.0f) + sh; }
        store_u_row(u, row, lane, Ub, c.ws + WS_U8, (float*)(c.ws + WS_SU));
    }
}
__device__ __forceinline__ void phase_g1a(LAS unsigned char* lds, int l, int wv) {
    const Ctx c = fresh_ctx(wv); const bool last = (l == DEPTH - 1);
    pg8::Gemm g{(const bf16*)(c.ws + WS_U), (const bf16*)(c.ws + WS_WIN + l * WIN_L) + (size_t)C_BF0 * DM, DM, DM, DM};
    pg8::Order S; S.init(last ? 32 : 34, (C_BF1 - C_BF0) / 256, c.G, c.vcu, 0); S.noremap = 1;
    if (last && c.G == 256) { S.seg = 1; S.sn0 = 2; S.sw0 = 256; S.sn1 = 1; S.sw1 = 248; S.sn2 = 1; S.sw2 = 136; }
    pg8::EpiBf16 E{(bf16*)(c.ws + WS_P) + C_BF0, INC, 1 << 30};
    pg8::gemm_phase<pg8::EpiBf16, pg8::Order, true, true, false>(lds + RING_OFF, g, S, E, c.tid);
}
__device__ __forceinline__ void phase_g1b(LAS unsigned char* lds, int l, int wv) {
    const Ctx c = fresh_ctx(wv); const bool last = (l == DEPTH - 1);
    pg8::Gemm g{(const bf16*)(c.ws + WS_U8), (const bf16*)(c.ws + WS_W8 + l * W8_L), DM / 2, DM / 2, DM / 2};
    const int nA = (last ? 32 : 34) * ((C_BF1 - C_BF0) / 256), nlong = nA % c.G, n3 = nlong ? c.G - nlong : c.G;
    pg8::Order S; S.init(last ? 32 : 34, NI8 / 256, c.G, (c.vcu + n3) % c.G, last ? 8 : 0, n3); S.noremap = 1;
    if (last && c.G == 256) { S.c = c.G - 1 - c.vcu; S.seg = 1; S.sn0 = 8; S.sw0 = 256; S.sn1 = 1; S.sw1 = 120; S.sn2 = 2; S.sw2 = 8; }
    pg8::EpiGateI8 E{(bf16*)(c.ws + WS_P), INC, (const float*)(c.ws + WS_SU), (const float*)(c.ws + WS_SW) + l * NI8};
    pg8::gemm_phase<pg8::EpiGateI8, pg8::Order, true, true, true>(lds + RING_OFF, g, S, E, c.tid);
}
__device__ __forceinline__ v4u norm_rope8b(v4u in, const f32x4 g0, const f32x4 g1, bool rope, bool first, const f32x4 c0, const f32x4 c1, const f32x4 s0, const f32x4 s1) {
    float f[8]; unpack8(in, f);
    float ss = 0.f;
#pragma unroll
    for (int e = 0; e < 8; ++e) ss += f[e] * f[e];
    ss = sum16(ss);
    const float rstd = 1.0f / sqrtf(ss * (1.0f / 128.0f) + EPS);
    float y[8];
#pragma unroll
    for (int e = 0; e < 4; ++e) { y[e] = f[e] * rstd * g0[e]; y[4 + e] = f[4 + e] * rstd * g1[e]; }
    if (rope) {
#pragma unroll
        for (int e = 0; e < 8; ++e) { const float py = lane_xor4(y[e]); const float cs = e < 4 ? c0[e & 3] : c1[e & 3], sn = e < 4 ? s0[e & 3] : s1[e & 3];
            y[e] = first ? (y[e] * cs - py * sn) : (y[e] * cs + py * sn); }
    }
    return pack8(y);
}
__device__ __forceinline__ void phase_t1_rows(int l, int wv) {
    const Ctx c = fresh_ctx(wv); const bool last = (l == DEPTH - 1); const int lane = c.lane;
    const float* qn = c.ap->in[7] + l * HD; const float* kn = c.ap->in[8] + l * HD; const float* cw = c.ap->in[9] + l * 3 * CONV_W;
    const float* cosT = (const float*)(c.ws + WS_ROPE); const float* sinT = cosT + 2048;
    const bf16* Pb = (const bf16*)(c.ws + WS_P); bf16* Qb = (bf16*)(c.ws + WS_Q); bf16* Kb = (bf16*)(c.ws + WS_K); bf16* Vb = (bf16*)(c.ws + WS_V); bf16* Yb = (bf16*)(c.ws + WS_Y);
    const int hl = lane & 15, j0 = (hl & 3) * 8; const bool first = (hl & 7) < 4;
    const f32x4 qg0 = *(const f32x4*)(qn + hl * 8), qg1 = *(const f32x4*)(qn + hl * 8 + 4), kg0 = *(const f32x4*)(kn + hl * 8), kg1 = *(const f32x4*)(kn + hl * 8 + 4);
    const int ngm = (last ? NLAT : MT) / 128 * 4, nx = (ngm > c.G && ngm < 2 * c.G) ? ngm - c.G : 0;
    if (c.vcu < nx) return;
    const int gw0 = (c.vcu - nx) * NWAVES + c.wave, ngw = (c.G - nx) * NWAVES;
#pragma unroll 1
    for (int row = gw0; row < MT; row += ngw) {
        const bool isctx = row >= NLAT;
        const int b = isctx ? ((row - NLAT) >> 8) : (row >> 12), t = isctx ? ((row - NLAT) & 255) : (row & 4095);
        const bf16* Prow = Pb + (size_t)row * INC;
        const size_t krow = (size_t)b * SKV + (isctx ? t : CTXL + t);
        const int pos = (hl >> 3) ? (t & 63) : (t >> 6);
        const f32x4 c0 = *(const f32x4*)(cosT + pos * 32 + j0), c1 = *(const f32x4*)(cosT + pos * 32 + j0 + 4);
        const f32x4 s0 = *(const f32x4*)(sinT + pos * 32 + j0), s1 = *(const f32x4*)(sinT + pos * 32 + j0 + 4);
        const v4u kin = *(const v4u*)(Prow + C_K + lane * 8), vin = *(const v4u*)(Prow + C_V + lane * 8);
        if (isctx && last) {
            *(v4u*)(Kb + krow * KV_W + lane * 8) = norm_rope8b(kin, kg0, kg1, false, first, c0, c1, s0, s1);
            *(v4u*)(Vb + krow * KV_W + lane * 8) = vin;
            continue;
        }
        v4u qin[4];
#pragma unroll
        for (int ch = 0; ch < 4; ++ch) qin[ch] = *(const v4u*)(Prow + C_Q + ch * 512 + lane * 8);
        const int seqlen = isctx ? CTXL : SEQ;
        const bool hasm = t > 0, hasp = t < seqlen - 1;
        const bf16* Pm = hasm ? Prow - INC : Prow; const bf16* Pp = hasp ? Prow + INC : Prow;
        const float m0 = hasm ? 1.f : 0.f, m2 = hasp ? 1.f : 0.f;
        v4u am[2], bm[2], a0[2], b0[2], ap[2], bp[2], cbw[2], cgw[2]; f32x4 w[2][6];
#pragma unroll
        for (int ch = 0; ch < 2; ++ch) { const int cc = ch * 512 + lane * 8;
            am[ch] = *(const v4u*)(Pm + C_CC + cc); bm[ch] = *(const v4u*)(Pm + C_CH + cc);
            a0[ch] = *(const v4u*)(Prow + C_CC + cc); b0[ch] = *(const v4u*)(Prow + C_CH + cc);
            ap[ch] = *(const v4u*)(Pp + C_CC + cc); bp[ch] = *(const v4u*)(Pp + C_CH + cc);
            cbw[ch] = *(const v4u*)(Prow + C_CB + cc); cgw[ch] = *(const v4u*)(Prow + C_CG + cc);
#pragma unroll
            for (int tp = 0; tp < 3; ++tp) { w[ch][2 * tp] = *(const f32x4*)(cw + tp * CONV_W + cc); w[ch][2 * tp + 1] = *(const f32x4*)(cw + tp * CONV_W + cc + 4); } }
#pragma unroll
        for (int ch = 0; ch < 4; ++ch) *(v4u*)(Qb + (size_t)row * ATTN_W + ch * 512 + lane * 8) = norm_rope8b(qin[ch], qg0, qg1, !isctx, first, c0, c1, s0, s1);
        *(v4u*)(Kb + krow * KV_W + lane * 8) = norm_rope8b(kin, kg0, kg1, !isctx, first, c0, c1, s0, s1);
        *(v4u*)(Vb + krow * KV_W + lane * 8) = vin;
#pragma unroll
        for (int ch = 0; ch < 2; ++ch) { const int cc = ch * 512 + lane * 8;
            float fa[8], fb[8], z0[8], z1[8], z2[8], cbv[8], cgv[8], y[8];
            unpack8(am[ch], fa); unpack8(bm[ch], fb);
#pragma unroll
            for (int e = 0; e < 8; ++e) z0[e] = fa[e] * fb[e] * m0;
            unpack8(a0[ch], fa); unpack8(b0[ch], fb);
#pragma unroll
            for (int e = 0; e < 8; ++e) z1[e] = fa[e] * fb[e];
            unpack8(ap[ch], fa); unpack8(bp[ch], fb);
#pragma unroll
            for (int e = 0; e < 8; ++e) z2[e] = fa[e] * fb[e] * m2;
            unpack8(cbw[ch], cbv); unpack8(cgw[ch], cgv);
#pragma unroll
            for (int e = 0; e < 8; ++e) { const float w0 = w[ch][e >> 2][e & 3], w1 = w[ch][2 + (e >> 2)][e & 3], w2 = w[ch][4 + (e >> 2)][e & 3];
                y[e] = cbv[e] * (w0 * z0[e] + w1 * z1[e] + w2 * z2[e]) * silu_f(cgv[e]); }
            *(v4u*)(Yb + (size_t)row * DM + ATTN_W + cc) = pack8(y); }
    }
}
struct GmOps { f32x4 wr[8]; v4u uw[4], gw[4], vs[4]; f32x4 ga0, ga1, be0, be1; float bias; };
struct GmCtx { int l, r0, wave, fr, fq; const bf16* Pb; bf16* Yb; const float* lng; const float* lnb; const float* gm_ws; const float* gm_b; };
__device__ __forceinline__ void gm_load(GmOps& o, const GmCtx& G, int g) {
    const float* Wsp = G.gm_ws + ((size_t)(G.l * 8 + g) * 128 + G.wave * 16 + G.fr) * 128 + G.fq * 8;
#pragma unroll
    for (int kk = 0; kk < 4; ++kk) { o.wr[2 * kk] = *(const f32x4*)(Wsp + kk * 32); o.wr[2 * kk + 1] = *(const f32x4*)(Wsp + kk * 32 + 4); }
    const size_t orow = (size_t)(G.r0 + G.wave * 16 + G.fr);
#pragma unroll
    for (int j = 0; j < 4; ++j) { const int d = g * 128 + 32 * G.fq + 8 * j; o.uw[j] = *(const v4u*)(G.Pb + orow * INC + C_GU + d); o.gw[j] = *(const v4u*)(G.Pb + orow * INC + C_GG + d); }
    o.bias = G.gm_b[(G.l * 8 + g) * 128 + G.wave * 16 + G.fr];
    const int gc = g * 128 + G.fr * 8;
    o.ga0 = *(const f32x4*)(G.lng + gc); o.ga1 = *(const f32x4*)(G.lng + gc + 4); o.be0 = *(const f32x4*)(G.lnb + gc); o.be1 = *(const f32x4*)(G.lnb + gc + 4);
#pragma unroll
    for (int bt = 0; bt < 4; ++bt) o.vs[bt] = *(const v4u*)(G.Pb + (size_t)(G.r0 + G.wave * 16 + bt * 4 + G.fq) * INC + C_GV + gc);
}
__device__ __forceinline__ void gm_norm(const GmOps& o, const GmCtx& G, const float (&mean)[4], const float (&rstd)[4], LAS bf16* vnT) {
#pragma unroll
    for (int bt = 0; bt < 4; ++bt) { const int rr = G.wave * 16 + bt * 4 + G.fq; float f[8]; unpack8(o.vs[bt], f);
#pragma unroll
        for (int e = 0; e < 8; ++e) { const float gg = e < 4 ? o.ga0[e & 3] : o.ga1[e & 3], bb = e < 4 ? o.be0[e & 3] : o.be1[e & 3];
            vnT[(e * 16 + G.fr) * 136 + rr] = (bf16)f2bf((f[e] - mean[bt]) * rstd[bt] * gg + bb); } }
}
__device__ __forceinline__ void gm_mma_epi(const GmOps& o, const GmCtx& G, int g, const LAS bf16* vnT) {
    const int fr = G.fr, fq = G.fq;
    f32x4 acc[8];
#pragma unroll
    for (int nb = 0; nb < 8; ++nb) acc[nb] = (f32x4){0.f, 0.f, 0.f, 0.f};
#pragma unroll
    for (int kk = 0; kk < 4; ++kk) {
        const f32x4 wa = o.wr[2 * kk], wb = o.wr[2 * kk + 1];
        v4u aw; aw.x = pk2(wa[0], wa[1]); aw.y = pk2(wa[2], wa[3]); aw.z = pk2(wb[0], wb[1]); aw.w = pk2(wb[2], wb[3]);
        const bf16x8 wf = __builtin_bit_cast(bf16x8, aw);
#pragma unroll
        for (int nb = 0; nb < 8; ++nb) { const bf16x8 vf = *(const LAS bf16x8*)(vnT + (nb * 16 + fr) * 136 + kk * 32 + fq * 8);
            acc[nb] = __builtin_amdgcn_mfma_f32_16x16x32_bf16(vf, wf, acc[nb], 0, 0, 0); }
    }
    const size_t orow = (size_t)(G.r0 + G.wave * 16 + fr);
#pragma unroll
    for (int j = 0; j < 4; ++j) { const int d = g * 128 + 32 * fq + 8 * j;
        float uf[8], gf[8], y[8]; unpack8(o.uw[j], uf); unpack8(o.gw[j], gf);
#pragma unroll
        for (int nb = 0; nb < 8; ++nb) y[nb] = uf[nb] * (acc[nb][j] + o.bias) * silu_f(gf[nb]);
        *(v4u*)(G.Yb + orow * DM + ATTN_W + CONV_W + d) = pack8(y); }
}
__device__ __forceinline__ void phase_t1_gmlp(LAS unsigned char* lds, int l, int wv) {
    const Ctx c = fresh_ctx(wv); const bool last = (l == DEPTH - 1); const int lane = c.lane, wave = c.wave;
    GmCtx G; G.l = l; G.wave = wave; G.fr = lane & 15; G.fq = lane >> 4; G.Pb = (const bf16*)(c.ws + WS_P); G.Yb = (bf16*)(c.ws + WS_Y);
    G.lng = c.ap->in[10] + l * GM_W; G.lnb = c.ap->in[11] + l * GM_W; G.gm_ws = c.ap->in[12]; G.gm_b = c.ap->in[13];
    const int nunits = (last ? NLAT : MT) / 128 * 4;
    LAS bf16* vnT0 = (LAS bf16*)(lds + RING_OFF); LAS bf16* vnT1 = vnT0 + 128 * 136;
    const int fr = G.fr, fq = G.fq;
#pragma unroll 1
    for (int uu = c.vcu; uu < nunits; uu += c.G) {
        const int cch = uu >> 2, gp = uu & 3; G.r0 = cch * 128;
        GmOps A; gm_load(A, G, 2 * gp);
        float mean[4], rstd[4];
#pragma unroll
        for (int hb = 0; hb < 2; ++hb) {
            v4u rv[2][8];
#pragma unroll
            for (int bt = 0; bt < 2; ++bt) { const bf16* Pv = G.Pb + (size_t)(G.r0 + wave * 16 + (hb * 2 + bt) * 4 + fq) * INC + C_GV;
#pragma unroll
                for (int j = 0; j < 8; ++j) rv[bt][j] = *(const v4u*)(Pv + j * 128 + fr * 8); }
#pragma unroll
            for (int bt = 0; bt < 2; ++bt) {
                float sm = 0.f;
#pragma unroll
                for (int j = 0; j < 8; ++j) { float f[8]; unpack8(rv[bt][j], f);
#pragma unroll
                    for (int e = 0; e < 8; ++e) sm += f[e]; }
                const float mn = sum16(sm) * (1.0f / 1024.0f);
                float q = 0.f;
#pragma unroll
                for (int j = 0; j < 8; ++j) { float f[8]; unpack8(rv[bt][j], f);
#pragma unroll
                    for (int e = 0; e < 8; ++e) { const float d0 = f[e] - mn; q += d0 * d0; } }
                mean[hb * 2 + bt] = mn; rstd[hb * 2 + bt] = 1.0f / sqrtf(sum16(q) * (1.0f / 1024.0f) + EPS); }
        }
        gm_norm(A, G, mean, rstd, vnT0);
        GmOps B; gm_load(B, G, 2 * gp + 1);
        __syncthreads();
        gm_mma_epi(A, G, 2 * gp, vnT0);
        gm_norm(B, G, mean, rstd, vnT1);
        __syncthreads();
        gm_mma_epi(B, G, 2 * gp + 1, vnT1);
    }
    __syncthreads();
}
__device__ __forceinline__ void phase_attn(char* lds_generic, int l, int wv) {
    const Ctx c = fresh_ctx(wv); const bool last = (l == DEPTH - 1);
    const bf16* Pb = (const bf16*)(c.ws + WS_P); const bf16* Qb = (const bf16*)(c.ws + WS_Q); const bf16* Kb = (const bf16*)(c.ws + WS_K); const bf16* Vb = (const bf16*)(c.ws + WS_V); bf16* Yb = (bf16*)(c.ws + WS_Y);
    const int NU = 512 + (last ? 0 : 32);
    for (int i = c.vcu; i < NU; i += c.G) {
        int b, h, row0, seq;
        if (i < 512) { b = i >> 8; h = ((i >> 6) & 3) * 4 + ((i >> 4) & 3); row0 = b * SEQ + (i & 15) * 256; seq = SKV; }
        else { const int e = i - 512; b = e >> 4; h = e & 15; row0 = NLAT + b * CTXL; seq = CTXL; }
        const int kvh = h >> 2;
        int tfresh = c.tid; asm volatile("" : "+v"(tfresh));
        attn::attn_dense_body((const attn::bf16*)(Qb + (size_t)row0 * ATTN_W + h * HD), (const attn::bf16*)(Kb + (size_t)b * SKV * KV_W + kvh * HD),
                              (const attn::bf16*)(Vb + (size_t)b * SKV * KV_W + kvh * HD), Pb + (size_t)row0 * INC + C_AG + h * HD, Yb + (size_t)row0 * DM + h * HD, seq, lds_generic + RING_OFF, tfresh);
    }
}
__device__ __forceinline__ void phase_g2(LAS unsigned char* lds, int l, int wv) {
    const Ctx c = fresh_ctx(wv); const bool last = (l == DEPTH - 1);
    pg8::Order S; S.init(last ? 32 : 34, DM / 256, c.G, c.vcu, 0); S.panel = 1;
    pg8::Gemm g{(const bf16*)(c.ws + WS_Y), (const bf16*)(c.ws + WS_WBR + l * WBR_L), DM, DM, DM};
    pg8::EpiMerge E{(const bf16*)(c.ws + WS_P) + C_MG, INC, c.ws + WS_MG8, DM, (unsigned*)(c.ws + WS_CTL + CTL_ROWMAX) + l * MT,
                    (unsigned*)(c.ws + WS_CTL + CTL_PCNT) + l * 64 * 64, 16u * 8u, (float*)(c.ws + WS_SM), (unsigned*)(c.ws + WS_CTL) + 2};
    pg8::gemm_phase<pg8::EpiMerge, pg8::Order, true, true, false>(lds + RING_OFF, g, S, E, c.tid);
}
__device__ __forceinline__ void phase_mq(int l, int wv) {
    const Ctx c = fresh_ctx(wv);
    if (l == 0) modv_reduce(c, 1);
}
__device__ __forceinline__ void phase_g3(LAS unsigned char* lds, int l, int wv) {
    const Ctx c = fresh_ctx(wv); const bool last = (l == DEPTH - 1);
    const bf16* XC = (const bf16*)(c.ws + WS_XC);
    pg8::Gemm g{(const bf16*)(c.ws + WS_MG8), (const bf16*)(c.ws + WS_W8O + l * W8O_L), DM / 2, DM / 2, DM / 2};
    pg8::Order S; S.init(last ? 32 : 34, DM / 256, c.G, c.vcu, 0); S.panel = 1;
    if (last) { pg8::EpiResLnI8<true, true> E{c.ws, l, XC, XC + (size_t)NLAT * DM, c.ap->in[18] + l * DM, c.ap->in[19] + l * DM, c.ap->out};
        pg8::gemm_phase<pg8::EpiResLnI8<true, true>, pg8::Order, true, true, true>(lds + RING_OFF, g, S, E, c.tid); }
    else { pg8::EpiResLnI8<false, false> E{c.ws, l, c.ap->in[0], c.ap->in[2], c.ap->in[18] + l * DM, c.ap->in[19] + l * DM, nullptr};
        pg8::gemm_phase<pg8::EpiResLnI8<false, false>, pg8::Order, true, true, true>(lds + RING_OFF, g, S, E, c.tid); }
}
__device__ __forceinline__ void phase_q1(int wv) {
    const Ctx c = fresh_ctx(wv);
    quantize_w8(c, 1, 0, NI8 + DM);
}
__global__ void __launch_bounds__(NWAVES * 64, 2) mega_fwd(Args args) {
    extern __shared__ __attribute__((aligned(16))) unsigned char lds_raw[];
    LAS unsigned char* lds = (LAS unsigned char*)lds_raw;
    volatile LAS unsigned* MISC = (volatile LAS unsigned*)(lds + MISC_OFF);
    for (int u = threadIdx.x; u < (LDS_BYTES - LDSCTL_OFF) / 4; u += NWAVES * 64) ((LAS unsigned*)(lds + LDSCTL_OFF))[u] = 0u;
    __syncthreads();
    (void)xcd_barrier_post((unsigned*)(args.ws + WS_CTL) + CW_BAR, MISC + 8);
    const int wv = __builtin_amdgcn_readfirstlane((int)threadIdx.x >> 6);
#define GRID_BAR() do { ArgsP ap_ = (ArgsP)__builtin_amdgcn_kernarg_segment_ptr(); asm volatile("" : "+s"(ap_)); XcdBarrier b_; b_.bar = (unsigned*)(ap_->ws + WS_CTL) + CW_BAR; b_.x = xb_xcc_id(); \
        b_.st = (volatile LAS unsigned*)(lds + MISC_OFF) + 8; xcd_barrier(b_, wv == 0 && lane_id_fresh() == 0); } while (0)
    phase_p0(lds, wv);
    GRID_BAR();
    phase_p1(wv);
    GRID_BAR();
    phase_p2(wv);
    GRID_BAR();
#pragma nounroll
    for (int l = 0; l < DEPTH; ++l) {
        phase_g1a(lds, l, wv);
        phase_g1b(lds, l, wv);
        if (l == 0) phase_tail_transposes(lds, 0, wv);
        GRID_BAR();
        phase_t1_rows(l, wv);
        phase_t1_gmlp(lds, l, wv);
        GRID_BAR();
        phase_attn((char*)lds_raw, l, wv);
        GRID_BAR();
        phase_g2(lds, l, wv);
        if (l == 0) phase_tail_transposes(lds, 1, wv);
        GRID_BAR();
        if (l == 0) { phase_mq(l, wv); GRID_BAR(); }
        phase_g3(lds, l, wv);
        if (l == 0) phase_tail_transposes(lds, 2, wv);
        if (l != DEPTH - 1) GRID_BAR();
    }
#undef GRID_BAR
}

extern "C" void kernel_launch(void* const* d_in, const int* in_sizes, int n_in, void* d_out, int out_size, void* d_ws, size_t ws_size, hipStream_t stream) {
    static int grid = 0;
    if (grid == 0) {
        if (n_in != 20 || in_sizes[0] != NLAT * DM || out_size != NLAT * DM || ws_size < WS_END) {
            fprintf(stderr, "kernel_launch: shape mismatch: n_in %d in0 %d out %d ws %zu (need >= %zu)\n", n_in, n_in > 0 ? in_sizes[0] : -1, out_size, ws_size, (size_t)WS_END); grid = -1; return; }
        int dev = 0, cus = 0, per_cu = 0;
        if (hipGetDevice(&dev) != hipSuccess || hipDeviceGetAttribute(&cus, hipDeviceAttributeMultiprocessorCount, dev) != hipSuccess) { fprintf(stderr, "kernel_launch: device query failed\n"); grid = -1; return; }
        if (hipFuncSetAttribute((const void*)mega_fwd, hipFuncAttributeMaxDynamicSharedMemorySize, LDS_BYTES) != hipSuccess) { fprintf(stderr, "kernel_launch: hipFuncSetAttribute failed\n"); grid = -1; return; }
        if (hipOccupancyMaxActiveBlocksPerMultiprocessor(&per_cu, (const void*)mega_fwd, NWAVES * 64, LDS_BYTES) != hipSuccess || per_cu < 1)
            fprintf(stderr, "kernel_launch: note: occupancy query reports %d workgroups per CU\n", per_cu);
        (void)hipGetLastError();
        grid = cus;
    }
    if (grid < 0) return;
    if (hipMemsetAsync((char*)d_ws + WS_CTL, 0, CTL_ZERO_BYTES, stream) != hipSuccess) { fprintf(stderr, "kernel_launch: hipMemsetAsync failed\n"); return; }
    Args a{};
    for (int i = 0; i < 20; ++i) a.in[i] = (const float*)d_in[i];
    a.out = (float*)d_out; a.ws = (unsigned char*)d_ws;
    hipLaunchKernelGGL(mega_fwd, dim3(grid), dim3(NWAVES * 64), LDS_BYTES, stream, a);
    const hipError_t le = hipPeekAtLastError();
    if (le != hipSuccess) fprintf(stderr, "kernel_launch: launch failed: %s\n", hipGetErrorName(le));
}
```

```cpp
#include <hip/hip_runtime.h>
#include <hip/hip_bf16.h>
#include <cstdio>
#include <cstdint>
#include <cmath>

constexpr int DM = 4096, NB = 2, SEQ = 4096, CTXL = 256, DEPTH = 2;
constexpr int NLAT = NB * SEQ, NCTX = NB * CTXL, MT = NLAT + NCTX;
constexpr int HD = 128, NQH = 16, NKVH = 4, ATTN_W = 2048, KV_W = 512, CONV_W = 1024, GM_W = 1024;
constexpr int INC = 24576;
constexpr int C_Q = 0, C_K = 2048, C_V = 2560, C_AG = 3072, C_CB = 5120, C_CC = 6144, C_CH = 7168, C_CG = 8192, C_GU = 9216, C_GV = 10240, C_GG = 11264, C_MG = 12288;
constexpr int C_BF0 = 5120, C_BF1 = 12288, NI8 = INC - (C_BF1 - C_BF0);
constexpr int SKV = CTXL + SEQ;
constexpr float EPS = 1e-6f;
constexpr float ALPHA_RES = 1.4142135623730951f;

constexpr size_t MiB = 1u << 20;
constexpr size_t WS_CTL = 0, CTL_ZERO_BYTES = 1 * MiB;
constexpr size_t WS_ROPE = 1 * MiB;
constexpr size_t WS_MOD = 2 * MiB;
constexpr int NKC = 64;
constexpr size_t WS_MODP = 4 * MiB;
constexpr size_t WS_WIN = 32 * MiB, WIN_L = 192 * MiB;
constexpr size_t WS_WBR = 416 * MiB, WBR_L = 32 * MiB;
constexpr size_t WS_WOUT = 480 * MiB, WOUT_L = 32 * MiB;
constexpr size_t WS_U = 544 * MiB;
constexpr size_t WS_P = 612 * MiB;
constexpr size_t WS_Q = 1020 * MiB;
constexpr size_t WS_K = 1054 * MiB, WS_V = 1063 * MiB;
constexpr size_t WS_Y = 1072 * MiB;
constexpr size_t WS_MG = 1140 * MiB;
constexpr size_t WS_MGF = 1208 * MiB;
constexpr size_t WS_R = 1344 * MiB;
constexpr size_t WS_XC = 1480 * MiB;
constexpr size_t WS_U8 = 1616 * MiB;
constexpr size_t WS_W8 = 1652 * MiB, W8_L = 68 * MiB;
constexpr size_t WS_SU = 1790 * MiB;
constexpr size_t WS_SW = 1791 * MiB;
constexpr size_t WS_W8O = 1792 * MiB, W8O_L = 16 * MiB;
constexpr size_t WS_MG8 = 1824 * MiB;
constexpr size_t WS_PMAXO = 1858 * MiB;
constexpr size_t WS_SWO = 1861 * MiB;
constexpr size_t WS_SM = 1862 * MiB;
constexpr size_t WS_END = 1863 * MiB;
constexpr size_t CTL_RS = 327680;
constexpr size_t CTL_UMAX = 622592;
constexpr size_t CTL_PCNT2 = 671744;
constexpr size_t CTL_PCNT = 262144;
constexpr size_t CTL_ROWMAX = 131072;
constexpr size_t WS_PMAX = 22 * MiB;
constexpr int CW_BAR = 4096;

namespace pg8 {
#define PG8_LAS __attribute__((address_space(3)))
#define PG8_GAS __attribute__((address_space(1)))
typedef unsigned short bf16_t;
typedef short bf16x8 __attribute__((ext_vector_type(8)));
typedef float f32x4 __attribute__((ext_vector_type(4)));
typedef unsigned u32x4 __attribute__((ext_vector_type(4)));
constexpr int BM = 256, BK = 64, HALF = 128, HTB = HALF * BK * 2  , STAGE_BYTES = 8 * HTB, NXCD = 8, WGM = 4;

__host__ __device__ __forceinline__ int lds_byte(int r, int c) { const int st = (r >> 4) * 2 + (c >> 5), rr = r & 15, cc = c & 31, ob = rr * 64 + cc * 2; return st * 1024 + (ob ^ (((ob >> 9) & 1) << 5)); }
__host__ __device__ __forceinline__ void stage_rc(int b, int& R, int& C) { const int st = b / 1024, sb = b % 1024, swz = sb ^ (((sb >> 9) & 1) << 5); R = (st >> 1) * 16 + swz / 64; C = (st & 1) * 32 + (swz % 64) / 2; }
__host__ __device__ __forceinline__ int perm32(int rho) { const int n = rho >> 4, i = rho & 15; return 8 * (i >> 2) + 4 * n + (i & 3); }

struct Unit { int pm, pn; };
struct Gemm { const bf16_t* A; const bf16_t* Bt; int lda, ldb, K; };

struct Order {
    int nM, nN, nwg, G, c, nextra;
    int noremap = 0;
    int panel = 0;
    int full, rem, n3;
    __host__ __device__ void init(int nM_, int nN_, int G_, int c_, int nextra_, int n3_ = 0) { nM = nM_; nN = nN_; nwg = nM * nN; G = G_; c = c_; nextra = nextra_;
        const int tot = nwg + nextra; full = tot / G; rem = tot % G; n3 = n3_ > 0 ? n3_ : G; }
    int seg = 0, sn0 = 0, sw0 = 0, sn1 = 0, sw1 = 0, sn2 = 0, sw2 = 0;
    __host__ __device__ bool next(int i, Unit& u) const {
        long L;
        if (seg) { int w, base;
            if (i < sn0) { w = sw0; base = i * sw0; } else if (i < sn0 + sn1) { w = sw1; base = sn0 * sw0 + (i - sn0) * sw1; } else if (i < sn0 + sn1 + sn2) { w = sw2; base = sn0 * sw0 + sn1 * sw1 + (i - sn0 - sn1) * sw2; } else return false;
            if (c >= w) return false;
            L = base + c; if (L >= nwg + nextra) return false; }
        else if (i < full) L = (long)i * G + c;
        else { const int idx = (i - full) * n3 + c; if (c >= n3 || idx >= rem) return false; L = (long)full * G + idx; }
        if (L >= nwg) { const int e = (int)(L - nwg); u.pm = 32 + (e >> 2); u.pn = 8 + (e & 3); return true; }
        if (panel) { u.pm = (int)(L / nN); u.pn = (int)(L % nN); return true; }
        int wgid = (int)L; if (!noremap) { const int q = nwg / NXCD, r = nwg % NXCD, xcd = wgid % NXCD, off = wgid / NXCD; wgid = (xcd < r ? xcd * (q + 1) : r * (q + 1) + (xcd - r) * q) + off; }
        const int nig = WGM * nN, gid = wgid / nig, fm = gid * WGM, gsz = (nM - fm) < WGM ? (nM - fm) : WGM;
        u.pm = fm + ((wgid % nig) % gsz); u.pn = (wgid % nig) / gsz; return true;
    }
    __device__ __forceinline__ void a_ready(const Unit&) const {}
    __device__ __forceinline__ void done(const Unit&) const {}
};

typedef float f32x2_t_ __attribute__((ext_vector_type(2)));
typedef __bf16 bf16x2_t_ __attribute__((ext_vector_type(2)));
__device__ __forceinline__ unsigned cvt_pk_bf16(float lo, float hi) { const f32x2_t_ v = {lo, hi}; return __builtin_bit_cast(unsigned, __builtin_convertvector(v, bf16x2_t_)); }
__device__ __forceinline__ float bf_lo(unsigned w) { return __uint_as_float(w << 16); }
__device__ __forceinline__ float bf_hi(unsigned w) { return __uint_as_float(w & 0xffff0000u); }
__device__ __forceinline__ float sigmoidf_(float x) { return __builtin_amdgcn_rcpf(1.0f + __expf(-x)); }

struct EpiBf16 {
    static constexpr bool PERM = true, AFTER_DRAIN = false;
    bf16_t* O; int ldc; int sig_from;
    __device__ __forceinline__ void operator()(const f32x4 (&acc)[2][2][4][2], const Unit& u, int wr, int wc, int fr, int fq) const {
        const int row0 = u.pm * BM + wr * 64 + fr, col0 = u.pn * BM + wc * 32 + 8 * fq;
#pragma unroll
        for (int ai = 0; ai < 2; ++ai)
#pragma unroll
            for (int m = 0; m < 4; ++m) { bf16_t* rowp = O + (size_t)(row0 + ai * HALF + m * 16) * ldc + col0;
#pragma unroll
                for (int bj = 0; bj < 2; ++bj) { f32x4 v0 = acc[ai][bj][m][0], v1 = acc[ai][bj][m][1];
                    if (u.pn >= sig_from) {
#pragma unroll
                        for (int e = 0; e < 4; ++e) { v0[e] = sigmoidf_(v0[e]); v1[e] = sigmoidf_(v1[e]); } }
                    u32x4 w; w.x = cvt_pk_bf16(v0[0], v0[1]); w.y = cvt_pk_bf16(v0[2], v0[3]); w.z = cvt_pk_bf16(v1[0], v1[1]); w.w = cvt_pk_bf16(v1[2], v1[3]);
                    *(u32x4*)(rowp + bj * HALF) = w; } }
    }
};
__device__ __forceinline__ void panel_wait(PG8_GAS unsigned* pc, unsigned need, PG8_GAS unsigned* tmo, int wr, int wc, int lane_) {
    asm volatile("s_waitcnt vmcnt(0) lgkmcnt(0)" ::: "memory");
    if (lane_ == 0) __hip_atomic_fetch_add(pc, 1u, __ATOMIC_RELAXED, __HIP_MEMORY_SCOPE_AGENT);
    if (wr == 0 && wc == 0) { unsigned spins = 0;
        while ((unsigned)__builtin_amdgcn_readfirstlane(__hip_atomic_load(pc, __ATOMIC_RELAXED, __HIP_MEMORY_SCOPE_AGENT)) < need) {
            __builtin_amdgcn_s_sleep(1);
            if (++spins > (1u << 20)) { if (lane_ == 0) __hip_atomic_store(tmo, 1u, __ATOMIC_RELAXED, __HIP_MEMORY_SCOPE_AGENT); break; } } }
    asm volatile("" ::: "memory"); __builtin_amdgcn_s_barrier(); asm volatile("" ::: "memory");
}
struct EpiMerge {
    static constexpr bool PERM = true, AFTER_DRAIN = false, HAS_MID = true;
    static constexpr int SEAM0 = ATTN_W / BK, SEAM1 = (ATTN_W + CONV_W) / BK;
    const bf16_t* gate; int ldg; unsigned char* mg8; int ldc; unsigned* rowmax; unsigned* pcnt; unsigned need; float* sm; unsigned* tmo;
    __device__ __forceinline__ void seam_mul(f32x4 (&acc)[2][2][4][2], int ai, int m, int bj, const u32x4 a, const u32x4 b) const {
        f32x4 r0, r1;
        r0[0] = bf_lo(a.x) * __builtin_amdgcn_rcpf(fmaxf(bf_lo(b.x), 1e-6f)); r0[1] = bf_hi(a.x) * __builtin_amdgcn_rcpf(fmaxf(bf_hi(b.x), 1e-6f));
        r0[2] = bf_lo(a.y) * __builtin_amdgcn_rcpf(fmaxf(bf_lo(b.y), 1e-6f)); r0[3] = bf_hi(a.y) * __builtin_amdgcn_rcpf(fmaxf(bf_hi(b.y), 1e-6f));
        r1[0] = bf_lo(a.z) * __builtin_amdgcn_rcpf(fmaxf(bf_lo(b.z), 1e-6f)); r1[1] = bf_hi(a.z) * __builtin_amdgcn_rcpf(fmaxf(bf_hi(b.z), 1e-6f));
        r1[2] = bf_lo(a.w) * __builtin_amdgcn_rcpf(fmaxf(bf_lo(b.w), 1e-6f)); r1[3] = bf_hi(a.w) * __builtin_amdgcn_rcpf(fmaxf(bf_hi(b.w), 1e-6f));
        acc[ai][bj][m][0] *= r0; acc[ai][bj][m][1] *= r1;
    }
    __device__ __forceinline__ void mid(f32x4 (&acc)[2][2][4][2], const Unit& u, int seg, int wr, int wc, int fr, int fq) const {
        asm volatile("" : "+v"(fr), "+v"(fq));
        const int row0 = u.pm * BM + wr * 64 + fr, col0 = u.pn * BM + wc * 32 + 8 * fq;
        u32x4 ga[4][2], gb[4][2], ha[4][2], hb[4][2];
#pragma unroll
        for (int m = 0; m < 4; ++m) { const bf16_t* gp = gate + (size_t)(row0 + m * 16) * ldg + seg * DM + col0;
#pragma unroll
            for (int bj = 0; bj < 2; ++bj) { ga[m][bj] = *(const u32x4*)(gp + bj * HALF); gb[m][bj] = *(const u32x4*)(gp + DM + bj * HALF); } }
#pragma unroll
        for (int m = 0; m < 4; ++m) {
#pragma unroll
            for (int bj = 0; bj < 2; ++bj) seam_mul(acc, 0, m, bj, ga[m][bj], gb[m][bj]);
            const bf16_t* gp = gate + (size_t)(row0 + HALF + m * 16) * ldg + seg * DM + col0;
#pragma unroll
            for (int bj = 0; bj < 2; ++bj) { ha[m][bj] = *(const u32x4*)(gp + bj * HALF); hb[m][bj] = *(const u32x4*)(gp + DM + bj * HALF); } }
#pragma unroll
        for (int m = 0; m < 4; ++m)
#pragma unroll
            for (int bj = 0; bj < 2; ++bj) seam_mul(acc, 1, m, bj, ha[m][bj], hb[m][bj]);
    }
    __device__ __forceinline__ void operator()(const f32x4 (&acc)[2][2][4][2], const Unit& u, int wr, int wc, int fr, int fq) const {
        const int row0 = u.pm * BM + wr * 64 + fr, col0 = u.pn * BM + wc * 32 + 8 * fq;
        f32x4 v[2][2][4][2];
#pragma unroll
        for (int ai = 0; ai < 2; ++ai) { u32x4 gl[4][2];
#pragma unroll
            for (int m = 0; m < 4; ++m)
#pragma unroll
                for (int bj = 0; bj < 2; ++bj) gl[m][bj] = *(const u32x4*)(gate + (size_t)(row0 + ai * HALF + m * 16) * ldg + 2 * DM + col0 + bj * HALF);
#pragma unroll
            for (int m = 0; m < 4; ++m) { const size_t row = (size_t)(row0 + ai * HALF + m * 16); float rmx = 0.f;
#pragma unroll
                for (int bj = 0; bj < 2; ++bj) { const int col = col0 + bj * HALF;
                    const u32x4 gv = gl[m][bj];
                    f32x4 g0, g1;
                    g0[0] = fmaxf(bf_lo(gv.x), 1e-6f); g0[1] = fmaxf(bf_hi(gv.x), 1e-6f); g0[2] = fmaxf(bf_lo(gv.y), 1e-6f); g0[3] = fmaxf(bf_hi(gv.y), 1e-6f);
                    g1[0] = fmaxf(bf_lo(gv.z), 1e-6f); g1[1] = fmaxf(bf_hi(gv.z), 1e-6f); g1[2] = fmaxf(bf_lo(gv.w), 1e-6f); g1[3] = fmaxf(bf_hi(gv.w), 1e-6f);
                    v[ai][bj][m][0] = acc[ai][bj][m][0] * g0; v[ai][bj][m][1] = acc[ai][bj][m][1] * g1;
#pragma unroll
                    for (int e = 0; e < 4; ++e) rmx = fmaxf(rmx, fmaxf(__builtin_fabsf(v[ai][bj][m][0][e]), __builtin_fabsf(v[ai][bj][m][1][e]))); }
                rmx = fmaxf(rmx, __shfl_xor(rmx, 16)); rmx = fmaxf(rmx, __shfl_xor(rmx, 32));
                if (fq == 0) __hip_atomic_fetch_max((PG8_GAS unsigned*)rowmax + row, __float_as_uint(rmx), __ATOMIC_RELAXED, __HIP_MEMORY_SCOPE_AGENT); } }
        panel_wait((PG8_GAS unsigned*)pcnt + 64 * u.pm, need, (PG8_GAS unsigned*)tmo, wr, wc, fr + 16 * fq);
        float mx8[2][4];
#pragma unroll
        for (int ai = 0; ai < 2; ++ai)
#pragma unroll
            for (int m = 0; m < 4; ++m) mx8[ai][m] = __uint_as_float(__hip_atomic_load((PG8_GAS unsigned*)rowmax + (size_t)(row0 + ai * HALF + m * 16), __ATOMIC_RELAXED, __HIP_MEMORY_SCOPE_AGENT));
#pragma unroll
        for (int ai = 0; ai < 2; ++ai)
#pragma unroll
            for (int m = 0; m < 4; ++m) { const size_t row = (size_t)(row0 + ai * HALF + m * 16);
                const float mx = mx8[ai][m];
                const float sc = mx > 0.f ? mx * (1.0f / 127.0f) : 1.0f, inv = 1.0f / sc;
                if (u.pn == 0 && wc == 0 && fq == 0) __hip_atomic_store((PG8_GAS float*)sm + row, sc, __ATOMIC_RELAXED, __HIP_MEMORY_SCOPE_AGENT);
#pragma unroll
                for (int bj = 0; bj < 2; ++bj) { int q[8];
#pragma unroll
                    for (int e = 0; e < 4; ++e) { q[e] = __float2int_rn(v[ai][bj][m][0][e] * inv); q[4 + e] = __float2int_rn(v[ai][bj][m][1][e] * inv); }
                    unsigned w0 = (unsigned)(q[0] & 255) | ((unsigned)(q[1] & 255) << 8) | ((unsigned)(q[2] & 255) << 16) | ((unsigned)(q[3] & 255) << 24);
                    unsigned w1 = (unsigned)(q[4] & 255) | ((unsigned)(q[5] & 255) << 8) | ((unsigned)(q[6] & 255) << 16) | ((unsigned)(q[7] & 255) << 24);
                    typedef unsigned u32x2_ __attribute__((ext_vector_type(2)));
                    *(u32x2_*)(mg8 + row * ldc + col0 + bj * HALF) = (u32x2_){w0, w1}; } }
    }
};
typedef int i32x4 __attribute__((ext_vector_type(4)));
template <class E, class = void> struct HasMid { static constexpr bool value = false; };
template <class E> struct HasMid<E, decltype((void)E::HAS_MID)> { static constexpr bool value = E::HAS_MID; };
template <bool I8> struct AccT;
template <> struct AccT<false> { typedef f32x4 type; static __device__ __forceinline__ f32x4 zero() { return (f32x4){0.f, 0.f, 0.f, 0.f}; } };
template <> struct AccT<true>  { typedef i32x4 type; static __device__ __forceinline__ i32x4 zero() { return (i32x4){0, 0, 0, 0}; } };
template <bool I8> __device__ __forceinline__ void mma1(typename AccT<I8>::type& c, const bf16x8& a, const bf16x8& b);
template <> __device__ __forceinline__ void mma1<false>(f32x4& c, const bf16x8& a, const bf16x8& b) { c = __builtin_amdgcn_mfma_f32_16x16x32_bf16(a, b, c, 0, 0, 0); }
template <> __device__ __forceinline__ void mma1<true>(i32x4& c, const bf16x8& a, const bf16x8& b) { c = __builtin_amdgcn_mfma_i32_16x16x64_i8(__builtin_bit_cast(i32x4, a), __builtin_bit_cast(i32x4, b), c, 0, 0, 0); }
struct EpiGateI8 {
    static constexpr bool PERM = true, AFTER_DRAIN = false;
    bf16_t* O; int ldc; const float* su; const float* sw;
    __device__ __forceinline__ void operator()(const i32x4 (&acc)[2][2][4][2], const Unit& u, int wr, int wc, int fr, int fq) const {
        const bool gate = u.pn >= C_BF0 / 256;
        const int row0 = u.pm * BM + wr * 64 + fr, cw = u.pn * BM + wc * 32 + 8 * fq, col0 = cw + (gate ? (C_BF1 - C_BF0) : 0);
        f32x4 cs[2][2];
#pragma unroll
        for (int bj = 0; bj < 2; ++bj)
#pragma unroll
            for (int n = 0; n < 2; ++n) cs[bj][n] = *(const f32x4*)(sw + cw + bj * HALF + 4 * n);
        float rs8[2][4];
#pragma unroll
        for (int ai = 0; ai < 2; ++ai)
#pragma unroll
            for (int m = 0; m < 4; ++m) rs8[ai][m] = su[row0 + ai * HALF + m * 16];
#pragma unroll
        for (int ai = 0; ai < 2; ++ai)
#pragma unroll
            for (int m = 0; m < 4; ++m) { const int row = row0 + ai * HALF + m * 16; const float rs = rs8[ai][m]; bf16_t* rowp = O + (size_t)row * ldc + col0;
#pragma unroll
                for (int bj = 0; bj < 2; ++bj) { f32x4 v0, v1;
#pragma unroll
                    for (int e = 0; e < 4; ++e) { v0[e] = (float)acc[ai][bj][m][0][e] * rs * cs[bj][0][e]; v1[e] = (float)acc[ai][bj][m][1][e] * rs * cs[bj][1][e]; }
                    if (gate) {
#pragma unroll
                        for (int e = 0; e < 4; ++e) { v0[e] = sigmoidf_(v0[e]); v1[e] = sigmoidf_(v1[e]); } }
                    u32x4 w; w.x = cvt_pk_bf16(v0[0], v0[1]); w.y = cvt_pk_bf16(v0[2], v0[3]); w.z = cvt_pk_bf16(v1[0], v1[1]); w.w = cvt_pk_bf16(v1[2], v1[3]);
                    *(u32x4*)(rowp + bj * HALF) = w; } }
    }
};

template <bool XBF, bool LAST> struct EpiResLnI8 {
    static constexpr bool PERM = true, AFTER_DRAIN = false;
    unsigned char* ws; int l; const void* xlat; const void* xctx; const float* lg; const float* lb; float* out;
    __device__ __forceinline__ void operator()(i32x4 (&acc)[2][2][4][2], const Unit& u, int wr, int wc, int fr, int fq) const {
        asm volatile("" : "+v"(fr), "+v"(fq));
        unsigned char* w_ = ws; int l_ = l; asm volatile("" : "+s"(w_), "+s"(l_));
        PG8_GAS unsigned char* wg = (PG8_GAS unsigned char*)w_;
        const PG8_GAS float* modv = (const PG8_GAS float*)(wg + WS_MOD) + l_ * 3 * 12288; const PG8_GAS float* mod1 = (const PG8_GAS float*)(wg + WS_MOD) + 3 * 12288; const float alpha = ALPHA_RES;
        const PG8_GAS float* sm = (const PG8_GAS float*)(wg + WS_SM); const PG8_GAS float* swo = (const PG8_GAS float*)(wg + WS_SWO) + l_ * DM;
        PG8_GAS bf16_t* xc = (PG8_GAS bf16_t*)(wg + WS_XC); PG8_GAS bf16_t* U = (PG8_GAS bf16_t*)(wg + WS_U); PG8_GAS unsigned char* U8 = wg + WS_U8; PG8_GAS float* su = (PG8_GAS float*)(wg + WS_SU);
        PG8_GAS unsigned long long* rs = (PG8_GAS unsigned long long*)(wg + WS_CTL + CTL_RS) + (size_t)l_ * 2 * MT; PG8_GAS unsigned* umax = (PG8_GAS unsigned*)(wg + WS_CTL + CTL_UMAX);
        PG8_GAS unsigned* pcnt = (PG8_GAS unsigned*)(wg + WS_CTL + CTL_PCNT2) + (l_ * 2 + 0) * 64 * 64; PG8_GAS unsigned* pcnt2 = (PG8_GAS unsigned*)(wg + WS_CTL + CTL_PCNT2) + (l_ * 2 + 1) * 64 * 64;
        PG8_GAS unsigned* tmo = (PG8_GAS unsigned*)(wg + WS_CTL) + 2; const unsigned need = 16u * 8u;
        const PG8_GAS float* lgp = (const PG8_GAS float*)lg; const PG8_GAS float* lbp = (const PG8_GAS float*)lb; PG8_GAS float* outp = (PG8_GAS float*)out;
        const int row0 = u.pm * BM + wr * 64 + fr, col0 = u.pn * BM + wc * 32 + 8 * fq, lane_ = fr + 16 * fq;
        const int which = u.pm < 16 ? 0 : (u.pm < 32 ? 1 : 2);
        const PG8_GAS float* gt = modv + which * 12288 + 8192;
#define RR(ai, bj, m, n) __builtin_bit_cast(f32x4, acc[ai][bj][m][n])
#define RW(ai, bj, m, n, v) acc[ai][bj][m][n] = __builtin_bit_cast(i32x4, (v))
        {   f32x4 gv[2][2];
#pragma unroll
            for (int bj = 0; bj < 2; ++bj)
#pragma unroll
                for (int n = 0; n < 2; ++n) gv[bj][n] = *(const PG8_GAS f32x4*)(gt + col0 + bj * HALF + 4 * n) * *(const PG8_GAS f32x4*)(swo + col0 + bj * HALF + 4 * n);
#pragma unroll
            for (int ai = 0; ai < 2; ++ai)
#pragma unroll
            for (int mh = 0; mh < (XBF ? 1 : 2); ++mh) {
              constexpr int MB = XBF ? 4 : 2;
              const PG8_GAS void* xb = (const PG8_GAS void*)((u.pm < 32) ? xlat : xctx);
              float rsc4[MB]; u32x4 xq[MB][2]; f32x4 xf[XBF ? 1 : MB][XBF ? 1 : 2][2];
#pragma unroll
              for (int mm = 0; mm < MB; ++mm) { const int m = mh * MB + mm; const int row = row0 + ai * HALF + m * 16; rsc4[mm] = sm[row];
                  const size_t xoff = (u.pm < 32) ? (size_t)row * DM : (size_t)(row - 8192) * DM;
#pragma unroll
                  for (int bj = 0; bj < 2; ++bj) { const int col = col0 + bj * HALF;
                      if (XBF) xq[mm][bj] = *(const PG8_GAS u32x4*)((const PG8_GAS bf16_t*)xb + xoff + col);
                      else { xf[XBF ? 0 : mm][XBF ? 0 : bj][0] = *(const PG8_GAS f32x4*)((const PG8_GAS float*)xb + xoff + col); xf[XBF ? 0 : mm][XBF ? 0 : bj][1] = *(const PG8_GAS f32x4*)((const PG8_GAS float*)xb + xoff + col + 4); } } }
#pragma unroll
                for (int mm = 0; mm < MB; ++mm) { const int m = mh * MB + mm; const int row = row0 + ai * HALF + m * 16; const float rsc = rsc4[mm];
                    float s1 = 0.f, s2 = 0.f;
#pragma unroll
                    for (int bj = 0; bj < 2; ++bj) { f32x4 x0, x1;
                        if (XBF) { const u32x4 xv = xq[mm][bj];
                            x0[0] = bf_lo(xv.x); x0[1] = bf_hi(xv.x); x0[2] = bf_lo(xv.y); x0[3] = bf_hi(xv.y); x1[0] = bf_lo(xv.z); x1[1] = bf_hi(xv.z); x1[2] = bf_lo(xv.w); x1[3] = bf_hi(xv.w); }
                        else { x0 = xf[XBF ? 0 : mm][XBF ? 0 : bj][0]; x1 = xf[XBF ? 0 : mm][XBF ? 0 : bj][1]; }
                        f32x4 a0, a1;
#pragma unroll
                        for (int e = 0; e < 4; ++e) { a0[e] = (float)acc[ai][bj][m][0][e]; a1[e] = (float)acc[ai][bj][m][1][e]; }
                        const f32x4 r0 = x0 * alpha + gv[bj][0] * rsc * a0, r1 = x1 * alpha + gv[bj][1] * rsc * a1;
                        RW(ai, bj, m, 0, r0); RW(ai, bj, m, 1, r1);
#pragma unroll
                        for (int e = 0; e < 4; ++e) { s1 += r0[e] + r1[e]; s2 += r0[e] * r0[e] + r1[e] * r1[e]; } }
                    s1 += __shfl_xor(s1, 16); s1 += __shfl_xor(s1, 32); s2 += __shfl_xor(s2, 16); s2 += __shfl_xor(s2, 32);
                    if (fq == 0) { __hip_atomic_fetch_add(rs + row, (unsigned long long)(long long)__float2ll_rn(s1 * 1048576.0f), __ATOMIC_RELAXED, __HIP_MEMORY_SCOPE_AGENT); __hip_atomic_fetch_add(rs + MT + row, (unsigned long long)(long long)__float2ll_rn(s2 * 4096.0f), __ATOMIC_RELAXED, __HIP_MEMORY_SCOPE_AGENT); } }  } }
        panel_wait(pcnt + 64 * u.pm, need, tmo, wr, wc, lane_);
        float mean[8], rstd[8];
        unsigned long long sv1[8], sv2[8];
#pragma unroll
        for (int ai = 0; ai < 2; ++ai)
#pragma unroll
            for (int m = 0; m < 4; ++m) { const int row = row0 + ai * HALF + m * 16;
                sv1[ai * 4 + m] = __hip_atomic_load(rs + row, __ATOMIC_RELAXED, __HIP_MEMORY_SCOPE_AGENT); sv2[ai * 4 + m] = __hip_atomic_load(rs + MT + row, __ATOMIC_RELAXED, __HIP_MEMORY_SCOPE_AGENT); }
#pragma unroll
        for (int ai = 0; ai < 2; ++ai)
#pragma unroll
            for (int m = 0; m < 4; ++m) {
                const float S1 = (float)(long long)sv1[ai * 4 + m] * (1.0f / 1048576.0f), S2 = (float)(long long)sv2[ai * 4 + m] * (1.0f / 4096.0f);
                const float mu = S1 * (1.0f / DM); mean[ai * 4 + m] = mu; rstd[ai * 4 + m] = 1.0f / sqrtf(fmaxf(S2 * (1.0f / DM) - mu * mu, 0.f) + EPS); }
        typedef unsigned u32x2_ __attribute__((ext_vector_type(2)));
#pragma unroll
        for (int bj = 0; bj < 2; ++bj) {
            f32x4 gS[2], bS[2], cS[LAST ? 1 : 2], hS[LAST ? 1 : 2];
#pragma unroll
            for (int n = 0; n < 2; ++n) { const int col = col0 + bj * HALF + 4 * n;
                gS[n] = *(const PG8_GAS f32x4*)(lgp + col); bS[n] = *(const PG8_GAS f32x4*)(lbp + col);
                if (!LAST) { const PG8_GAS float* m1 = mod1 + which * 12288; cS[LAST ? 0 : n] = *(const PG8_GAS f32x4*)(m1 + DM + col); hS[LAST ? 0 : n] = *(const PG8_GAS f32x4*)(m1 + col); } }
#pragma unroll
            for (int n = 0; n < 2; ++n) { const int col = col0 + bj * HALF + 4 * n;
                const f32x4 g = gS[n], b = bS[n];
                f32x4 cc = g, hh = g;
                if (!LAST) { cc = cS[LAST ? 0 : n] + 1.0f; hh = hS[LAST ? 0 : n]; }
#pragma unroll
                for (int ai = 0; ai < 2; ++ai)
#pragma unroll
                    for (int m = 0; m < 4; ++m) { const unsigned eo = (unsigned)(row0 + ai * HALF + m * 16) * (unsigned)DM + (unsigned)col;
                        const f32x4 nn = (RR(ai, bj, m, n) - mean[ai * 4 + m]) * rstd[ai * 4 + m] * g + b;
                        if (LAST) *(PG8_GAS f32x4*)(outp + eo) = nn;
                        else { u32x2_ w; w.x = cvt_pk_bf16(nn[0], nn[1]); w.y = cvt_pk_bf16(nn[2], nn[3]); *(PG8_GAS u32x2_*)(xc + eo) = w;
                            const f32x4 uu = nn * cc + hh; RW(ai, bj, m, n, uu);
                            w.x = cvt_pk_bf16(uu[0], uu[1]); w.y = cvt_pk_bf16(uu[2], uu[3]); *(PG8_GAS u32x2_*)(U + eo) = w; } } } }
        if (!LAST) {
#pragma unroll
            for (int ai = 0; ai < 2; ++ai)
#pragma unroll
                for (int m = 0; m < 4; ++m) { float mx = 0.f;
#pragma unroll
                    for (int bj = 0; bj < 2; ++bj)
#pragma unroll
                        for (int n = 0; n < 2; ++n)
#pragma unroll
                            for (int e = 0; e < 4; ++e) mx = fmaxf(mx, __builtin_fabsf(RR(ai, bj, m, n)[e]));
                    mx = fmaxf(mx, __shfl_xor(mx, 16)); mx = fmaxf(mx, __shfl_xor(mx, 32));
                    if (fq == 0) __hip_atomic_fetch_max(umax + row0 + ai * HALF + m * 16, __float_as_uint(mx), __ATOMIC_RELAXED, __HIP_MEMORY_SCOPE_AGENT); }
            panel_wait(pcnt2 + 64 * u.pm, need, tmo, wr, wc, lane_);
            float umx8[2][4];
#pragma unroll
            for (int ai = 0; ai < 2; ++ai)
#pragma unroll
                for (int m = 0; m < 4; ++m) umx8[ai][m] = __uint_as_float(__hip_atomic_load(umax + (unsigned)(row0 + ai * HALF + m * 16), __ATOMIC_RELAXED, __HIP_MEMORY_SCOPE_AGENT));
#pragma unroll
            for (int ai = 0; ai < 2; ++ai)
#pragma unroll
                for (int m = 0; m < 4; ++m) { const unsigned row = (unsigned)(row0 + ai * HALF + m * 16);
                    const float mx = umx8[ai][m];
                    const float sc = mx > 0.f ? mx * (1.0f / 127.0f) : 1.0f, inv = 1.0f / sc;
                    if (u.pn == 0 && wc == 0 && fq == 0) __hip_atomic_store(su + row, sc, __ATOMIC_RELAXED, __HIP_MEMORY_SCOPE_AGENT);
#pragma unroll
                    for (int bj = 0; bj < 2; ++bj) { int q[8];
#pragma unroll
                        for (int e = 0; e < 4; ++e) { q[e] = __float2int_rn(RR(ai, bj, m, 0)[e] * inv); q[4 + e] = __float2int_rn(RR(ai, bj, m, 1)[e] * inv); }
                        const unsigned w0 = (unsigned)(q[0] & 255) | ((unsigned)(q[1] & 255) << 8) | ((unsigned)(q[2] & 255) << 16) | ((unsigned)(q[3] & 255) << 24);
                        const unsigned w1 = (unsigned)(q[4] & 255) | ((unsigned)(q[5] & 255) << 8) | ((unsigned)(q[6] & 255) << 16) | ((unsigned)(q[7] & 255) << 24);
                        *(PG8_GAS u32x2_*)(U8 + (row * (unsigned)DM + (unsigned)(col0 + bj * HALF))) = (u32x2_){w0, w1}; } }
        }
    }
};
#undef RR
#undef RW
template <class Epi, class Sched, bool ALIGN_EPI = false, bool SP2 = false, bool I8 = false>
__device__ __forceinline__ void gemm_phase(PG8_LAS unsigned char* lds, const Gemm g, const Sched& S, const Epi& E, const int tid) {
    const int wid = __builtin_amdgcn_readfirstlane(tid >> 6), lane = tid & 63, wr = wid >> 2, wc = wid & 3, fr = lane & 15, fq = lane >> 4;
    const int K = g.K, nt = K / BK;
    unsigned voffA[2], voffB[2];
#pragma unroll
    for (int i = 0; i < 2; ++i) { int R, C; stage_rc(tid * 16 + i * 8192, R, C); const int Rb = Epi::PERM ? ((R & ~31) + perm32(R & 31)) : R;
        voffA[i] = (unsigned)(R * g.lda + C) * 2u; voffB[i] = (unsigned)(Rb * g.ldb + C) * 2u; }
    const size_t kstep = (size_t)(BK * 2);
    const size_t hstepA = (size_t)HALF * g.lda * 2, hstepB = (size_t)HALF * g.ldb * 2;
    const size_t tstepA = 2 * hstepA, tstepB = 2 * hstepB;
    const unsigned ldsw = (unsigned)wid * 1024u;
    const int aoff = lds_byte(wr * 64 + fr, fq * 8), boff = lds_byte(wc * 32 + fr, fq * 8);
#define PG8_SA(b, h) (((b) * 2 + (h)) * HTB)
#define PG8_SB(b, h) ((4 + (b) * 2 + (h)) * HTB)
#define PG8_STAGE(bufoff, gbase, voff) do { _Pragma("unroll") for (int _i = 0; _i < 2; ++_i) \
        __builtin_amdgcn_global_load_lds((const unsigned*)((const char*)(gbase) + (voff)[_i]), (PG8_LAS unsigned*)(lds + (bufoff) + ldsw + _i * 8192), 16, 0, 0); } while (0)
#define PG8_LDA(dst, b, h) do { _Pragma("unroll") for (int m = 0; m < 4; ++m) _Pragma("unroll") for (int k = 0; k < 2; ++k) dst[m][k] = *(const PG8_LAS bf16x8*)(lds + PG8_SA(b, h) + aoff + m * 2048 + k * 1024); } while (0)
#define PG8_LDB(dst, b, h) do { _Pragma("unroll") for (int n = 0; n < 2; ++n) _Pragma("unroll") for (int k = 0; k < 2; ++k) dst[n][k] = *(const PG8_LAS bf16x8*)(lds + PG8_SB(b, h) + boff + n * 2048 + k * 1024); } while (0)
#define PG8_MMA(ai, bj, At, Bt) do { __builtin_amdgcn_s_setprio(1); _Pragma("unroll") for (int m = 0; m < 4; ++m) _Pragma("unroll") for (int n = 0; n < 2; ++n) _Pragma("unroll") for (int k = 0; k < 2; ++k) \
        mma1<I8>(acc[ai][bj][m][n], Bt[n][k], At[m][k]); __builtin_amdgcn_s_setprio(0); } while (0)
#define PG8_WAIT_V(n) asm volatile("s_waitcnt vmcnt(" #n ")" ::: "memory")
#define PG8_WAIT_L(n) asm volatile("s_waitcnt lgkmcnt(" #n ")" ::: "memory")
#define PG8_BAR __builtin_amdgcn_s_barrier()
#define PG8_SCHED __builtin_amdgcn_sched_barrier(0)
    Unit cur, nxt; int ui = 0;
    if (!S.next(0, cur)) return;
    typename AccT<I8>::type acc[2][2][4][2];
#pragma unroll
    for (int a = 0; a < 2; ++a)
#pragma unroll
        for (int b = 0; b < 2; ++b)
#pragma unroll
            for (int m = 0; m < 4; ++m)
#pragma unroll
                for (int n = 0; n < 2; ++n) acc[a][b][m][n] = AccT<I8>::zero();
    bf16x8 At[4][2], B0[2][2], B1[2][2];
    const char* cA = (const char*)g.A + (size_t)cur.pm * tstepA; const char* cB = (const char*)g.Bt + (size_t)cur.pn * tstepB;
    S.a_ready(cur);
    if constexpr (SP2) {
        PG8_STAGE(PG8_SB(0, 0), cB, voffB); PG8_STAGE(PG8_SB(0, 1), cB + hstepB, voffB); PG8_STAGE(PG8_SA(0, 0), cA, voffA); PG8_STAGE(PG8_SA(0, 1), cA + hstepA, voffA);
        if (wr == 1) PG8_BAR;
        PG8_WAIT_V(2); PG8_BAR;
        PG8_STAGE(PG8_SB(1, 0), cB + kstep, voffB); PG8_STAGE(PG8_SA(1, 0), cA + kstep, voffA); PG8_STAGE(PG8_SB(1, 1), cB + hstepB + kstep, voffB);
        PG8_WAIT_V(6); PG8_BAR;
    } else {
        PG8_STAGE(PG8_SB(0, 0), cB, voffB); PG8_STAGE(PG8_SA(0, 0), cA, voffA); PG8_STAGE(PG8_SB(0, 1), cB + hstepB, voffB); PG8_STAGE(PG8_SA(0, 1), cA + hstepA, voffA);
        if (wr == 1) PG8_BAR;
        PG8_WAIT_V(4); PG8_BAR;
        PG8_STAGE(PG8_SB(1, 0), cB + kstep, voffB); PG8_STAGE(PG8_SA(1, 0), cA + kstep, voffA); PG8_STAGE(PG8_SB(1, 1), cB + hstepB + kstep, voffB);
        PG8_WAIT_V(6); PG8_BAR;
    }
    for (;;) {
        const bool has_next = S.next(ui + 1, nxt);
        const char* nA = has_next ? (const char*)g.A + (size_t)nxt.pm * tstepA : cA; const char* nB = has_next ? (const char*)g.Bt + (size_t)nxt.pn * tstepB : cB;
        for (int t = 0; t < nt; t += 2) {
            const bool last = (t == nt - 2);
            const char* a1 = cA + (size_t)(t + 1) * kstep;
            const char* a2 = last ? nA : cA + (size_t)(t + 2) * kstep; const char* b2 = last ? nB : cB + (size_t)(t + 2) * kstep;
            const char* a3 = a2 + kstep; const char* b3 = b2 + kstep;
            if (last && has_next) S.a_ready(nxt);
            if constexpr (SP2) {
            PG8_LDB(B0, 0, 0); PG8_LDB(B1, 0, 1); PG8_SCHED; PG8_LDA(At, 0, 0); PG8_STAGE(PG8_SA(1, 1), a1 + hstepA, voffA);
            PG8_WAIT_V(8); PG8_WAIT_L(0); PG8_BAR; PG8_MMA(0, 0, At, B0); PG8_MMA(0, 1, At, B1); PG8_BAR; PG8_SCHED;
            PG8_LDA(At, 0, 1); PG8_STAGE(PG8_SB(0, 0), b2, voffB); PG8_STAGE(PG8_SB(0, 1), b2 + hstepB, voffB); PG8_STAGE(PG8_SA(0, 0), a2, voffA);
            PG8_WAIT_V(8); PG8_WAIT_L(0); PG8_BAR; PG8_MMA(1, 0, At, B0); PG8_MMA(1, 1, At, B1); PG8_BAR; PG8_SCHED;
            PG8_LDB(B0, 1, 0); PG8_LDB(B1, 1, 1); PG8_SCHED; PG8_LDA(At, 1, 0); PG8_STAGE(PG8_SA(0, 1), a2 + hstepA, voffA);
            PG8_WAIT_V(8); PG8_WAIT_L(0); PG8_BAR; PG8_MMA(0, 0, At, B0); PG8_MMA(0, 1, At, B1); PG8_BAR; PG8_SCHED;
            PG8_LDA(At, 1, 1); PG8_STAGE(PG8_SB(1, 0), b3, voffB); PG8_STAGE(PG8_SB(1, 1), b3 + hstepB, voffB); PG8_STAGE(PG8_SA(1, 0), a3, voffA);
            PG8_WAIT_V(8); PG8_WAIT_L(0); PG8_BAR; PG8_MMA(1, 0, At, B0); PG8_MMA(1, 1, At, B1); PG8_BAR; PG8_SCHED;
            if constexpr (HasMid<Epi>::value) { if (t + 2 == Epi::SEAM0 || t + 2 == Epi::SEAM1) E.mid(acc, cur, t + 2 == Epi::SEAM0 ? 0 : 1, wr, wc, fr, fq); }
            } else {
            PG8_LDB(B0, 0, 0); PG8_SCHED; PG8_LDA(At, 0, 0); PG8_STAGE(PG8_SA(1, 1), a1 + hstepA, voffA);
            PG8_WAIT_L(8); PG8_BAR; PG8_WAIT_L(0); PG8_MMA(0, 0, At, B0); PG8_BAR; PG8_SCHED;
            PG8_LDB(B1, 0, 1); PG8_STAGE(PG8_SB(0, 0), b2, voffB);
            PG8_BAR; PG8_WAIT_L(0); PG8_MMA(0, 1, At, B1); PG8_BAR;
            PG8_LDA(At, 0, 1); PG8_STAGE(PG8_SA(0, 0), a2, voffA);
            PG8_BAR; PG8_WAIT_L(0); PG8_MMA(1, 0, At, B0); PG8_BAR; PG8_SCHED;
            PG8_STAGE(PG8_SB(0, 1), b2 + hstepB, voffB);
            PG8_WAIT_V(6); PG8_BAR; PG8_MMA(1, 1, At, B1); PG8_BAR;
            PG8_LDB(B0, 1, 0); PG8_SCHED; PG8_LDA(At, 1, 0); PG8_STAGE(PG8_SA(0, 1), a2 + hstepA, voffA);
            PG8_WAIT_L(8); PG8_BAR; PG8_WAIT_L(0); PG8_MMA(0, 0, At, B0); PG8_BAR; PG8_SCHED;
            PG8_LDB(B1, 1, 1); PG8_STAGE(PG8_SB(1, 0), b3, voffB);
            PG8_BAR; PG8_WAIT_L(0); PG8_MMA(0, 1, At, B1); PG8_BAR;
            PG8_LDA(At, 1, 1); PG8_STAGE(PG8_SA(1, 0), a3, voffA);
            PG8_BAR; PG8_WAIT_L(0); PG8_MMA(1, 0, At, B0); PG8_BAR; PG8_SCHED;
            PG8_STAGE(PG8_SB(1, 1), b3 + hstepB, voffB);
            PG8_WAIT_V(6); PG8_BAR; PG8_MMA(1, 1, At, B1); PG8_BAR;
            }
        }
        if constexpr (ALIGN_EPI) { if (wr == 0) PG8_BAR; }
        if constexpr (!Epi::AFTER_DRAIN) { E(acc, cur, wr, wc, fr, fq); S.done(cur); }
        if (!has_next) break;
#pragma unroll
        for (int a = 0; a < 2; ++a)
#pragma unroll
            for (int b = 0; b < 2; ++b)
#pragma unroll
                for (int m = 0; m < 4; ++m)
#pragma unroll
                    for (int n = 0; n < 2; ++n) acc[a][b][m][n] = AccT<I8>::zero();
        cur = nxt; cA = nA; cB = nB; ++ui;
        if constexpr (ALIGN_EPI) { if (wr == 1) PG8_BAR; }
    }
    PG8_WAIT_V(0);
    if constexpr (!ALIGN_EPI) { if (wr == 0) PG8_BAR; }
    PG8_BAR;
    if constexpr (Epi::AFTER_DRAIN) { E.fused(acc, cur, wr, wc, fr, fq, lds, wid, lane); S.done(cur); }
#undef PG8_SA
#undef PG8_SB
#undef PG8_STAGE
#undef PG8_LDA
#undef PG8_LDB
#undef PG8_MMA
#undef PG8_WAIT_V
#undef PG8_WAIT_L
#undef PG8_BAR
#undef PG8_SCHED
}
}

namespace attn {
using bf16 = __hip_bfloat16;
constexpr int   D = 128, NW = 8, QBLK = 32, KVBLK = 64;
constexpr float SCALE = 0.088388347648318440f;
constexpr float THR = 8.f;
constexpr int SDEPTH = 2;
constexpr int LDQ = 2048, LDK = 512, LDG = 24576, LDY = 4096;
constexpr size_t SHM_V = KVBLK * D * 2, SHM_K = KVBLK * D * 2, SHM_ATTN = 2 * SHM_V + 2 * SHM_K + NW * 64 * 4;
using bf16x8 = __attribute__((ext_vector_type(8))) short;
using s16x4  = __attribute__((ext_vector_type(4))) short;
using f32x16 = __attribute__((ext_vector_type(16))) float;
using f32x8  = __attribute__((ext_vector_type(8))) float;
using u32x4  = __attribute__((ext_vector_type(4))) unsigned;
#define KSWZ(row, colB) ((row) * 256 + ((colB) ^ (((row) & 7) << 4)))
#define SBAR() __builtin_amdgcn_sched_barrier(0)
__device__ __forceinline__ int crow(int r, int hi) { return (r & 3) + 8 * (r >> 2) + 4 * hi; }
__device__ __forceinline__ unsigned cvtpk(float lo, float hi) { return pg8::cvt_pk_bf16(lo, hi); }
template <typename TIn> struct Stage;
template <> struct Stage<bf16>  { using T = bf16x8;
  __device__ static __forceinline__ T ld8(const bf16* p) { return *reinterpret_cast<const bf16x8*>(p); }
  __device__ static __forceinline__ bf16x8 tobf(T x) { return x; } };
template <> struct Stage<float> { using T = f32x8;
  __device__ static __forceinline__ T ld8(const float* p) { return *reinterpret_cast<const f32x8*>(p); }
  __device__ static __forceinline__ bf16x8 tobf(T x) {
    u32x4 w = {cvtpk(x[0], x[1]), cvtpk(x[2], x[3]), cvtpk(x[4], x[5]), cvtpk(x[6], x[7])}; return *reinterpret_cast<bf16x8*>(&w); } };

__device__ __forceinline__ void partialSM(f32x16& p0, f32x16& p1, float& m_reg, float& mn, float& alpha) {
  constexpr float C = SCALE * 1.4426950408889634f;
  float pmax = p0[0]; for (int r = 1; r < 16; ++r) pmax = fmaxf(pmax, p0[r]); for (int r = 0; r < 16; ++r) pmax = fmaxf(pmax, p1[r]);
  { auto rr = __builtin_amdgcn_permlane32_swap(__float_as_uint(pmax), __float_as_uint(pmax), false, false);
    pmax = fmaxf(__uint_as_float(rr[0]), __uint_as_float(rr[1])); }
  if (__builtin_expect(__all(pmax - m_reg <= THR / SCALE), 1)) { mn = m_reg; alpha = 1.f; }
  else { mn = fmaxf(m_reg, pmax); alpha = __builtin_amdgcn_exp2f((m_reg - mn) * C); m_reg = mn; }
  float mnC = -mn * C;
  for (int r = 0; r < 16; ++r) p0[r] = fmaf(p0[r], C, mnC); for (int r = 0; r < 16; ++r) p1[r] = fmaf(p1[r], C, mnC);
  for (int r = 0; r < 16; ++r) p0[r] = __builtin_amdgcn_exp2f(p0[r]);
}
__device__ __forceinline__ void finishSM(f32x16& p0, f32x16& p1, float alpha, float& l_reg, bf16x8& pa0, bf16x8& pa1, bf16x8& pa2, bf16x8& pa3) {
  for (int r = 0; r < 16; ++r) p1[r] = __builtin_amdgcn_exp2f(p1[r]);
  float ps = 0; for (int r = 0; r < 16; ++r) ps += p0[r]; for (int r = 0; r < 16; ++r) ps += p1[r];
  { auto rr = __builtin_amdgcn_permlane32_swap(__float_as_uint(ps), __float_as_uint(ps), false, false);
    ps = __uint_as_float(rr[0]) + __uint_as_float(rr[1]); }
  l_reg = l_reg * alpha + ps;
#define PK4(P, BASE, OUT) do { unsigned a0 = cvtpk(P[BASE + 0], P[BASE + 1]), a1 = cvtpk(P[BASE + 2], P[BASE + 3]);   \
    unsigned b0 = cvtpk(P[BASE + 4], P[BASE + 5]), b1 = cvtpk(P[BASE + 6], P[BASE + 7]);                              \
    auto r0 = __builtin_amdgcn_permlane32_swap(a0, b0, false, false); auto r1 = __builtin_amdgcn_permlane32_swap(a1, b1, false, false); \
    u32x4 w = {r0[0], r1[0], r0[1], r1[1]}; OUT = *reinterpret_cast<bf16x8*>(&w); } while (0)
  PK4(p0, 0, pa0); PK4(p0, 8, pa1); PK4(p1, 0, pa2); PK4(p1, 8, pa3);
#undef PK4
}
__device__ __forceinline__ void qkt(f32x16& p0, f32x16& p1, const bf16* Ks, const bf16x8* qr, int r32, int hi) {
  p0 = f32x16{}; p1 = f32x16{};
  for (int d0 = 0; d0 < 8; ++d0) { int cb = (d0 * 16 + hi * 8) * 2;
    bf16x8 b0 = *reinterpret_cast<const bf16x8*>((const char*)Ks + KSWZ(r32, cb));
    bf16x8 b1 = *reinterpret_cast<const bf16x8*>((const char*)Ks + KSWZ(32 + r32, cb));
    p0 = __builtin_amdgcn_mfma_f32_32x32x16_bf16(b0, qr[d0], p0, 0, 0, 0);
    p1 = __builtin_amdgcn_mfma_f32_32x32x16_bf16(b1, qr[d0], p1, 0, 0, 0); }
}
__device__ __forceinline__ int v_st(int k, int c) { const int kk = (k & ~0xC) | ((k & 4) << 1) | ((k & 8) >> 1); return ((kk >> 3) * 4 + (c >> 5)) * 512 + ((kk & 7) * 32 + (c & 31)) * 2; }
__device__ __forceinline__ int v_rd_base(int lane) { return ((lane & 3) << 3) | (((lane >> 2) & 3) << 6) | (((lane >> 4) & 1) << 5) | (((lane >> 5) & 1) << 8); }
constexpr int v_rd_off(int d0, int ks, int half) { return d0 * 512 + ks * 4096 + half * 2048; }
template <int OFF> __device__ __forceinline__ s16x4 tr_read(int vb) {
  s16x4 r; asm volatile("ds_read_b64_tr_b16 %0, %1 offset:%2" : "=&v"(r) : "v"(vb), "i"(OFF) : "memory"); return r;
}
template <int D0> __device__ __forceinline__ void pv_one(f32x16& od, int vb, bf16x8 pa0, bf16x8 pa1, bf16x8 pa2, bf16x8 pa3) {
  const s16x4 l0 = tr_read<v_rd_off(D0, 0, 0)>(vb), h0 = tr_read<v_rd_off(D0, 0, 1)>(vb), l1 = tr_read<v_rd_off(D0, 1, 0)>(vb), h1 = tr_read<v_rd_off(D0, 1, 1)>(vb);
  const s16x4 l2 = tr_read<v_rd_off(D0, 2, 0)>(vb), h2 = tr_read<v_rd_off(D0, 2, 1)>(vb), l3 = tr_read<v_rd_off(D0, 3, 0)>(vb), h3 = tr_read<v_rd_off(D0, 3, 1)>(vb);
  asm volatile("s_waitcnt lgkmcnt(0)" ::: "memory"); SBAR();
#define PK(L, H) (bf16x8){L[0], L[1], L[2], L[3], H[0], H[1], H[2], H[3]}
  od = __builtin_amdgcn_mfma_f32_32x32x16_bf16(pa0, PK(l0, h0), od, 0, 0, 0);
  od = __builtin_amdgcn_mfma_f32_32x32x16_bf16(pa1, PK(l1, h1), od, 0, 0, 0);
  od = __builtin_amdgcn_mfma_f32_32x32x16_bf16(pa2, PK(l2, h2), od, 0, 0, 0);
  od = __builtin_amdgcn_mfma_f32_32x32x16_bf16(pa3, PK(l3, h3), od, 0, 0, 0);
#undef PK
}
__device__ __forceinline__ void pv_d0(f32x16* o, int vb, bf16x8 pa0, bf16x8 pa1, bf16x8 pa2, bf16x8 pa3) {
  pv_one<0>(o[0], vb, pa0, pa1, pa2, pa3); pv_one<1>(o[1], vb, pa0, pa1, pa2, pa3); pv_one<2>(o[2], vb, pa0, pa1, pa2, pa3); pv_one<3>(o[3], vb, pa0, pa1, pa2, pa3);
}
__device__ __forceinline__ void attn_dense_body(const bf16* __restrict__ Qb, const bf16* __restrict__ Kh, const bf16* __restrict__ Vh,
                                                const unsigned short* __restrict__ Gb, unsigned short* __restrict__ Yb, int seq, char* lds, const int tid) {
  using TQ = bf16; using St = Stage<bf16>; using SQ = Stage<TQ>;
  const int wid = tid >> 6, lane = tid & 63, r32 = lane & 31, hi = lane >> 5;
  bf16* V_lds = (bf16*)lds; bf16* K_lds = (bf16*)(lds + 2 * SHM_V);
  float* ws = (float*)(lds + 2 * SHM_V + 2 * SHM_K) + wid * 64; float* li_l = ws; float* al_l = ws + 32;
  float m_reg = -1e30f, l_reg = 0; f32x16 o[4] = {}; bf16x8 qr[8];
  const TQ* Qw = Qb + (long)(wid * QBLK + r32) * LDQ + hi * 8;
#pragma unroll
  for (int d0 = 0; d0 < 8; ++d0) qr[d0] = SQ::tobf(SQ::ld8(Qw + d0 * 16));
  const int sr = tid >> 4, sc = (tid & 15) * 8, vst0 = v_st(sr, sc), vst1 = v_st(32 + sr, sc);
  const int vb0 = (int)(uintptr_t)V_lds + v_rd_base(lane);
  struct { typename St::T vs0, vs1, ks0, ks1; } sr_[SDEPTH];
#define SLOAD(i, k0) do { sr_[i].vs0 = St::ld8(&Vh[(long)((k0) + sr) * LDK + sc]); sr_[i].vs1 = St::ld8(&Vh[(long)((k0) + 32 + sr) * LDK + sc]); \
    sr_[i].ks0 = St::ld8(&Kh[(long)((k0) + sr) * LDK + sc]); sr_[i].ks1 = St::ld8(&Kh[(long)((k0) + 32 + sr) * LDK + sc]); } while (0)
#define SWRITE(b, i) do { *(bf16x8*)((char*)V_lds + (b) * SHM_V + vst0) = St::tobf(sr_[i].vs0);          \
    *(bf16x8*)((char*)V_lds + (b) * SHM_V + vst1) = St::tobf(sr_[i].vs1); int kc = sc * 2;               \
    *(bf16x8*)((char*)K_lds + (b) * SHM_K + KSWZ(sr, kc)) = St::tobf(sr_[i].ks0);                       \
    *(bf16x8*)((char*)K_lds + (b) * SHM_K + KSWZ(32 + sr, kc)) = St::tobf(sr_[i].ks1); } while (0)
#define SWAIT() do { if constexpr (SDEPTH == 2) asm volatile("s_waitcnt vmcnt(4)" ::: "memory"); else asm volatile("s_waitcnt vmcnt(0)" ::: "memory"); } while (0)
#define RESC(a) do { if (__any((a) < 1.f)) { if (hi == 0) al_l[r32] = (a); asm volatile("s_waitcnt lgkmcnt(0)" ::: "memory"); \
    for (int d = 0; d < 4; ++d) for (int r = 0; r < 16; ++r) o[d][r] *= al_l[crow(r, hi)]; } } while (0)
  f32x16 pA0, pA1, pB0, pB1; float mnA, mnB, alA, alB; bf16x8 pa0, pa1, pa2, pa3; const int NT = seq / KVBLK;
  constexpr int SE = 0, SO = SDEPTH - 1;
  SLOAD(SE, 0); asm volatile("s_waitcnt vmcnt(0)" ::: "memory"); SWRITE(0, SE); __syncthreads();
  qkt(pA0, pA1, K_lds, qr, r32, hi); partialSM(pA0, pA1, m_reg, mnA, alA);
  SLOAD(SO, KVBLK); if constexpr (SDEPTH == 2) { if (2 < NT) SLOAD(SE, 2 * KVBLK); }
  SWAIT(); SWRITE(1, SO); __syncthreads();
  for (int j = 1; j + 1 < NT; j += 2) {
    SBAR(); qkt(pB0, pB1, (bf16*)((char*)K_lds + SHM_K), qr, r32, hi);
    finishSM(pA0, pA1, alA, l_reg, pa0, pa1, pa2, pa3); SBAR();
    SLOAD(SO, (j + SDEPTH) * KVBLK); SBAR();
    pv_d0(o, vb0, pa0, pa1, pa2, pa3); partialSM(pB0, pB1, m_reg, mnB, alB);
    __syncthreads(); SWAIT(); SWRITE(0, SE);
    RESC(alB); __syncthreads();
    SBAR(); qkt(pA0, pA1, K_lds, qr, r32, hi);
    finishSM(pB0, pB1, alB, l_reg, pa0, pa1, pa2, pa3); SBAR();
    if (SDEPTH == 1 || j + 3 < NT) SLOAD(SE, (j + 1 + SDEPTH) * KVBLK); SBAR();
    pv_d0(o, vb0 + (int)SHM_V, pa0, pa1, pa2, pa3); partialSM(pA0, pA1, m_reg, mnA, alA);
    __syncthreads(); SWAIT(); SWRITE(1, SO);
    RESC(alA); __syncthreads();
  }
  const unsigned short* Gw = Gb + (long)(wid * QBLK) * LDG;
  const int rsub = lane >> 4, c8 = (lane & 15) * 8;
  u32x4 gv[8];
#pragma unroll
  for (int it = 0; it < 8; ++it) gv[it] = *reinterpret_cast<const u32x4*>(Gw + (long)(it * 4 + rsub) * LDG + c8);
  SBAR(); qkt(pB0, pB1, (bf16*)((char*)K_lds + SHM_K), qr, r32, hi);
  finishSM(pA0, pA1, alA, l_reg, pa0, pa1, pa2, pa3); SBAR();
  pv_d0(o, vb0, pa0, pa1, pa2, pa3); partialSM(pB0, pB1, m_reg, mnB, alB);
  __syncthreads(); RESC(alB);
  finishSM(pB0, pB1, alB, l_reg, pa0, pa1, pa2, pa3); SBAR();
  pv_d0(o, vb0 + (int)SHM_V, pa0, pa1, pa2, pa3);
  if (hi == 0) li_l[r32] = l_reg; asm volatile("s_waitcnt lgkmcnt(0)" ::: "memory");
  float rli[16];
#pragma unroll
  for (int r = 0; r < 16; ++r) rli[r] = __builtin_amdgcn_rcpf(li_l[crow(r, hi)]);
  __syncthreads();
  { typedef __attribute__((address_space(3))) char lds_char; lds_char* ost = (lds_char*)lds + wid * 8192;
    const unsigned stb = (unsigned)(r32 * 2);
#pragma unroll
    for (int r = 0; r < 16; ++r) { const int orow = crow(r, hi);
#pragma unroll
      for (int d0 = 0; d0 < 4; ++d0) { const float v = o[d0][r] * rli[r]; unsigned u = __float_as_uint(v); u = (u + 0x7fffu + ((u >> 16) & 1u)) >> 16;
        *(__attribute__((address_space(3))) unsigned short*)(ost + orow * 256 + ((d0 * 64 + stb) ^ ((orow & 4) << 4))) = (unsigned short)u; } }
    asm volatile("s_waitcnt lgkmcnt(0)" ::: "memory");
    unsigned short* Yw = Yb + (long)(wid * QBLK) * LDY;
#pragma unroll
    for (int it = 0; it < 8; ++it) { const int row = it * 4 + rsub;
      const u32x4 ov = *(const __attribute__((address_space(3))) u32x4*)(ost + row * 256 + ((c8 * 2) ^ ((row & 4) << 4)));
      u32x4 w;
#pragma unroll
      for (int q = 0; q < 4; ++q) { const unsigned oo = ov[q], gg = gv[it][q];
        const float o_lo = __uint_as_float(oo << 16), o_hi = __uint_as_float(oo & 0xffff0000u), g_lo = __uint_as_float(gg << 16), g_hi = __uint_as_float(gg & 0xffff0000u);
        const float y_lo = o_lo * g_lo * __builtin_amdgcn_rcpf(1.0f + __expf(-g_lo)), y_hi = o_hi * g_hi * __builtin_amdgcn_rcpf(1.0f + __expf(-g_hi));
        w[q] = cvtpk(y_lo, y_hi); }
      *reinterpret_cast<u32x4*>(Yw + (long)row * LDY + c8) = w; } }
  __syncthreads();
#undef SLOAD
#undef SWRITE
#undef SWAIT
#undef RESC
}
}

constexpr int NWAVES = 8;
constexpr int RING_OFF = 0, RING_BYTES = 131072;
constexpr int LDSCTL_OFF = RING_BYTES, MISC_OFF = LDSCTL_OFF + 320;
constexpr int LDS_BYTES = 147456;

#define GAS __attribute__((address_space(1)))
#define LAS __attribute__((address_space(3)))
typedef unsigned short bf16;
typedef unsigned v4u __attribute__((ext_vector_type(4)));
typedef unsigned v2u __attribute__((ext_vector_type(2)));
typedef float f32x4 __attribute__((ext_vector_type(4)));
typedef short bf16x8 __attribute__((ext_vector_type(8)));
typedef GAS unsigned gu32;
#define RLX_AGENT __ATOMIC_RELAXED, __HIP_MEMORY_SCOPE_AGENT
#define LDS_WAIT() asm volatile("s_waitcnt lgkmcnt(0)" ::: "memory")
#define VM_WAIT() asm volatile("s_waitcnt vmcnt(0)" ::: "memory")
__device__ __forceinline__ unsigned f2bf(float f) { unsigned u = __builtin_bit_cast(unsigned, f); return (u + 0x7fffu + ((u >> 16) & 1u)) >> 16; }
__device__ __forceinline__ unsigned pk2(float lo, float hi) { return pg8::cvt_pk_bf16(lo, hi); }
__device__ __forceinline__ float bflo(unsigned w) { return __uint_as_float(w << 16); }
__device__ __forceinline__ float bfhi(unsigned w) { return __uint_as_float(w & 0xffff0000u); }
__device__ __forceinline__ float silu_f(float x) { return x * __builtin_amdgcn_rcpf(1.0f + __expf(-x)); }
__device__ __forceinline__ void unpack8(v4u w, float (&f)[8]) { f[0] = bflo(w.x); f[1] = bfhi(w.x); f[2] = bflo(w.y); f[3] = bfhi(w.y); f[4] = bflo(w.z); f[5] = bfhi(w.z); f[6] = bflo(w.w); f[7] = bfhi(w.w); }
__device__ __forceinline__ v4u pack8(const float (&f)[8]) { v4u w; w.x = pk2(f[0], f[1]); w.y = pk2(f[2], f[3]); w.z = pk2(f[4], f[5]); w.w = pk2(f[6], f[7]); return w; }
__device__ __forceinline__ float wave_sum(float v) {
#pragma unroll
    for (int o = 1; o < 64; o <<= 1) v += __shfl_xor(v, o);
    return v;
}

template <int CTRL> __device__ __forceinline__ float dpp_f(float v) { return __builtin_bit_cast(float, __builtin_amdgcn_update_dpp(0, __builtin_bit_cast(int, v), CTRL, 0xF, 0xF, true)); }
__device__ __forceinline__ float sum16(float v) {
    v += dpp_f<0xB1>(v); v += dpp_f<0x4E>(v); v += dpp_f<0x141>(v); v += dpp_f<0x140>(v); return v; }
__device__ __forceinline__ float lane_xor4(float v) {
    const int s = __builtin_bit_cast(int, v);
    int t = __builtin_amdgcn_update_dpp(0, s, 0x104, 0xF, 0x5, false);
    t = __builtin_amdgcn_update_dpp(t, s, 0x114, 0xF, 0xA, false);
    return __builtin_bit_cast(float, t); }

#define XB_TMO      128
#define XB_XCNT(j)  (256  + 64 * (j))
#define XB_XSUB(j)  (1280 + 64 * (j))
#define XB_XGEN(j)  (2304 + 64 * (j))
#define XB_TOP      3328
#define XB_TOPGEN   3392
#define XCD_BAR_WORDS 3456
#define XB_SPIN_CAP (1u << 18)

__device__ __forceinline__ unsigned xb_ld(unsigned* p)              { return __hip_atomic_load(p, __ATOMIC_RELAXED, __HIP_MEMORY_SCOPE_AGENT); }
__device__ __forceinline__ unsigned xb_add(unsigned* p, unsigned v) { return __hip_atomic_fetch_add(p, v, __ATOMIC_RELAXED, __HIP_MEMORY_SCOPE_AGENT); }
__device__ __forceinline__ unsigned xb_xcc_id() { return (unsigned)__builtin_amdgcn_s_getreg((3 << 11) | 20) & 0xFu; }
#define XB_SPIN(cond, bar) do { unsigned _sp = 0; while (cond) { __builtin_amdgcn_s_sleep(1); \
    if ((++_sp & 255u) == 0u) { if (xb_ld(&(bar)[XB_TMO])) break; if (_sp > XB_SPIN_CAP) { atomicAdd(&(bar)[XB_TMO], 1u); break; } } } } while (0)

struct XcdBarrier {
    unsigned* bar; unsigned x;
    volatile LAS unsigned* st;
};

__device__ __forceinline__ XcdBarrier xcd_barrier_post(unsigned* bar, volatile LAS unsigned* st) {
    XcdBarrier b; b.bar = bar; b.x = xb_xcc_id(); b.st = st;
    if (threadIdx.x == 0) (void)xb_add(&bar[XB_XCNT(b.x)], 1u);
    return b;
}
__device__ __forceinline__ void xcd_barrier_complete(unsigned* bar, unsigned x, unsigned& nloc, unsigned& nx) {
    const unsigned G = gridDim.x * gridDim.y * gridDim.z;
    unsigned sum, cnt, mine, sp = 0u;
    for (;;) {
        sum = 0u; cnt = 0u; mine = 0u;
#pragma unroll
        for (unsigned j = 0; j < 16; ++j) { const unsigned c = xb_ld(&bar[XB_XCNT(j)]); sum += c; cnt += (c > 0u) ? 1u : 0u; mine = (j == x) ? c : mine; }
        if (sum == G) break;
        __builtin_amdgcn_s_sleep(1);
        if ((++sp & 255u) == 0u) { if (xb_ld(&bar[XB_TMO])) break; if (sp > XB_SPIN_CAP) { atomicAdd(&bar[XB_TMO], 1u); break; } }
    }
    nloc = mine > 0u ? mine : 1u; nx = cnt > 0u ? cnt : 1u;
}

__device__ __forceinline__ void xcd_barrier(const XcdBarrier& b, const bool t0) {
    asm volatile("s_waitcnt vmcnt(0)" ::: "memory");
    __syncthreads();
    if (t0) {
        unsigned* bar = b.bar;
        __builtin_amdgcn_s_waitcnt(0);
        unsigned nloc = b.st[0], nx = b.st[1];
        if (nloc == 0u) { xcd_barrier_complete(bar, b.x, nloc, nx); b.st[0] = nloc; b.st[1] = nx; }
        const unsigned old = xb_add(&bar[XB_XSUB(b.x)], 1u);
        const unsigned gen = old / nloc;
        if (old + 1u == (gen + 1u) * nloc) {
            __builtin_amdgcn_fence(__ATOMIC_RELEASE, "agent");
            asm volatile("s_waitcnt vmcnt(0)" ::: "memory");
            const unsigned og = xb_add(&bar[XB_TOP], 1u);
            const unsigned tg = og / nx;
            if (og + 1u == (tg + 1u) * nx) xb_add(&bar[XB_TOPGEN], 1u);
            else XB_SPIN(xb_ld(&bar[XB_TOPGEN]) == tg, bar);
            __builtin_amdgcn_fence(__ATOMIC_ACQUIRE, "agent");
            xb_add(&bar[XB_XGEN(b.x)], 1u);
            asm volatile("s_waitcnt vmcnt(0)" ::: "memory");
        } else {
            XB_SPIN(xb_ld(&bar[XB_XGEN(b.x)]) == gen, bar);
            __builtin_amdgcn_fence(__ATOMIC_ACQUIRE, "agent");
            asm volatile("s_waitcnt vmcnt(0)" ::: "memory");
        }
    }
    __syncthreads();
}

__device__ __forceinline__ void p0_transpose_item(const float* W, int K, int N, bf16* WT, int item, int lane, float* cmax = nullptr, int cmode = 1, int ldw = 0, int koff = 0) {
    const int nblk = N / 64, kbk = item / nblk, nb = item % nblk, k0 = 64 * kbk + 8 * (lane >> 3), n0 = 64 * nb + 4 * (lane & 7);
    f32x4 v[2][8];
#pragma unroll
    for (int h = 0; h < 2; ++h)
#pragma unroll
        for (int e = 0; e < 8; ++e) v[h][e] = __builtin_nontemporal_load((const f32x4*)(W + (size_t)(k0 + e) * N + n0 + 32 * h));
#pragma unroll
    for (int h = 0; h < 2; ++h)
#pragma unroll
        for (int j = 0; j < 4; ++j) { v4u o; o.x = pk2(v[h][0][j], v[h][1][j]); o.y = pk2(v[h][2][j], v[h][3][j]); o.z = pk2(v[h][4][j], v[h][5][j]); o.w = pk2(v[h][6][j], v[h][7][j]);
            *(v4u*)(WT + (size_t)(n0 + 32 * h + j) * (ldw ? ldw : K) + koff + k0) = o; }
    if (cmax && (cmode == 2 || n0 < C_BF0 || n0 >= C_BF1)) { const int q0 = (cmode == 2 || n0 < C_BF0) ? n0 : n0 - (C_BF1 - C_BF0); const int cpitch = cmode == 2 ? DM : NI8;
#pragma unroll
        for (int h = 0; h < 2; ++h) { f32x4 mx4;
#pragma unroll
            for (int j = 0; j < 4; ++j) { float mx = 0.f;
#pragma unroll
                for (int e = 0; e < 8; ++e) mx = fmaxf(mx, fabsf(v[h][e][j]));
                mx = fmaxf(mx, __shfl_xor(mx, 8)); mx = fmaxf(mx, __shfl_xor(mx, 16)); mx = fmaxf(mx, __shfl_xor(mx, 32)); mx4[j] = mx; }
            if (lane < 8) *(f32x4*)(cmax + (size_t)kbk * cpitch + q0 + 32 * h) = mx4; }
    }
}
__device__ __forceinline__ void sincos_d(double a, float& c, float& s) {
    const double k = __builtin_rint(a * 0.15915494309189535);
    double r = __builtin_fma(-k, 6.283185307179586, a); r = __builtin_fma(-k, 2.4492935982947064e-16, r);
    const double r2 = r * r;
    double q = -r2;
    double sn = 3.8681701706306835e-23;
    sn = sn * q + 1.9572941063391263e-20; sn = sn * q + 8.22063524662433e-18; sn = sn * q + 2.8114572543455206e-15; sn = sn * q + 7.647163731819816e-13;
    sn = sn * q + 1.6059043836821613e-10; sn = sn * q + 2.505210838544172e-08; sn = sn * q + 2.7557319223985893e-06; sn = sn * q + 0.0001984126984126984;
    sn = sn * q + 0.008333333333333333; sn = sn * q + 0.16666666666666666; sn = sn * q + 1.0; sn = sn * r;
    double cs = 1.6117375710961184e-24;
    cs = cs * q + 8.896791392450574e-22; cs = cs * q + 4.110317623312165e-19; cs = cs * q + 1.5619206968586225e-16; cs = cs * q + 4.779477332387385e-14;
    cs = cs * q + 1.1470745597729725e-11; cs = cs * q + 2.08767569878681e-09; cs = cs * q + 2.755731922398589e-07; cs = cs * q + 2.48015873015873e-05;
    cs = cs * q + 0.001388888888888889; cs = cs * q + 0.041666666666666664; cs = cs * q + 0.5; cs = cs * q + 1.0;
    c = (float)cs; s = (float)sn;
}
__device__ __forceinline__ v4u norm_rope8(v4u in, const float* gain8, bool rope, int hl, int pos0, int pos1, const float* cosT, const float* sinT) {
    float f[8]; unpack8(in, f);
    float ss = 0.f;
#pragma unroll
    for (int e = 0; e < 8; ++e) ss += f[e] * f[e];
    ss += __shfl_xor(ss, 1); ss += __shfl_xor(ss, 2); ss += __shfl_xor(ss, 4); ss += __shfl_xor(ss, 8);
    const float rstd = 1.0f / sqrtf(ss * (1.0f / 128.0f) + EPS);
    const f32x4 g0 = *(const f32x4*)gain8, g1 = *(const f32x4*)(gain8 + 4);
    float y[8];
#pragma unroll
    for (int e = 0; e < 4; ++e) { y[e] = f[e] * rstd * g0[e]; y[4 + e] = f[4 + e] * rstd * g1[e]; }
    if (rope) {
        const int pos = (hl >> 3) ? pos1 : pos0, j0 = (hl & 3) * 8; const bool first = (hl & 7) < 4;
        const f32x4 c0 = *(const f32x4*)(cosT + pos * 32 + j0), c1 = *(const f32x4*)(cosT + pos * 32 + j0 + 4);
        const f32x4 s0 = *(const f32x4*)(sinT + pos * 32 + j0), s1 = *(const f32x4*)(sinT + pos * 32 + j0 + 4);
#pragma unroll
        for (int e = 0; e < 8; ++e) { const float py = __shfl_xor(y[e], 4); const float cs = e < 4 ? c0[e & 3] : c1[e & 3], sn = e < 4 ? s0[e & 3] : s1[e & 3];
            y[e] = first ? (y[e] * cs - py * sn) : (y[e] * cs + py * sn); }
    }
    return pack8(y);
}

struct Args { const float* in[20]; float* out; unsigned char* ws; };
typedef const Args __attribute__((address_space(4))) * ArgsP;
struct Ctx { int tid, lane, wave, gw, NGW, G, bx, vcu; ArgsP ap; unsigned char* ws; };
__device__ __forceinline__ int lane_id_fresh() { int ln; asm volatile("v_mbcnt_lo_u32_b32 %0, -1, 0\n\tv_mbcnt_hi_u32_b32 %0, -1, %0" : "=v"(ln)); return ln; }
__device__ __forceinline__ Ctx fresh_ctx(int wv) {
    Ctx c; int t = wv * 64 + lane_id_fresh(); c.tid = t; c.lane = t & 63; c.wave = wv;
    int G = gridDim.x, bx = blockIdx.x; asm volatile("" : "+s"(G), "+s"(bx));
    c.G = G; c.bx = bx; c.vcu = (G % 8 == 0) ? (bx % 8) * (G / 8) + bx / 8 : bx;
    c.gw = c.vcu * NWAVES + c.wave; c.NGW = G * NWAVES;
    ArgsP ap = (ArgsP)__builtin_amdgcn_kernarg_segment_ptr(); asm volatile("" : "+s"(ap)); c.ap = ap; c.ws = ap->ws;
    return c;
}

__device__ __forceinline__ void weight_transposes(const Ctx& c, int l, int it0, int it1, int w, int nw) {
    unsigned char* ws = c.ws; const int lane = c.lane;
    const float* w_in = c.ap->in[6]; const float* w_br_attn = c.ap->in[14]; const float* w_br_conv = c.ap->in[15]; const float* w_br_gm = c.ap->in[16]; const float* w_out = c.ap->in[17];
    for (int it = it0 + w; it < it1; it += nw) {
        int r = it;
        if (r < 24576) { p0_transpose_item(w_in + (size_t)l * DM * INC, DM, INC, (bf16*)(ws + WS_WIN + l * WIN_L), r, lane, (float*)(ws + WS_PMAX) + (size_t)l * 64 * NI8); continue; } r -= 24576;
        if (r < 2048) { p0_transpose_item(w_br_attn + (size_t)l * ATTN_W * DM, ATTN_W, DM, (bf16*)(ws + WS_WBR + l * WBR_L), r, lane, nullptr, 1, DM, 0); continue; } r -= 2048;
        if (r < 1024) { p0_transpose_item(w_br_conv + (size_t)l * CONV_W * DM, CONV_W, DM, (bf16*)(ws + WS_WBR + l * WBR_L), r, lane, nullptr, 1, DM, ATTN_W); continue; } r -= 1024;
        if (r < 1024) { p0_transpose_item(w_br_gm + (size_t)l * GM_W * DM, GM_W, DM, (bf16*)(ws + WS_WBR + l * WBR_L), r, lane, nullptr, 1, DM, ATTN_W + CONV_W); continue; } r -= 1024;
        p0_transpose_item(w_out + (size_t)l * DM * DM, DM, DM, (bf16*)(ws + WS_WOUT + l * WOUT_L), r, lane, (float*)(ws + WS_PMAXO) + (size_t)l * 64 * DM, 2);
    }
}
__device__ __forceinline__ float wave_max(float v) {
    v = fmaxf(v, dpp_f<0xB1>(v)); v = fmaxf(v, dpp_f<0x4E>(v)); v = fmaxf(v, dpp_f<0x141>(v)); v = fmaxf(v, dpp_f<0x140>(v));
    const float a = __builtin_bit_cast(float, __builtin_amdgcn_readlane(__builtin_bit_cast(int, v), 0)), b = __builtin_bit_cast(float, __builtin_amdgcn_readlane(__builtin_bit_cast(int, v), 16));
    const float cc = __builtin_bit_cast(float, __builtin_amdgcn_readlane(__builtin_bit_cast(int, v), 32)), d = __builtin_bit_cast(float, __builtin_amdgcn_readlane(__builtin_bit_cast(int, v), 48));
    return fmaxf(fmaxf(a, b), fmaxf(cc, d)); }
struct QRow { const float* pm; float* swp; const bf16* src; unsigned char* dst; };
__device__ __forceinline__ QRow qrow(const Ctx& c, int l, int nn) {
    const bool wo = nn >= NI8; const int n = wo ? nn - NI8 : nn, col = wo ? n : (n < C_BF0 ? n : n + (C_BF1 - C_BF0));
    QRow r;
    r.pm = wo ? (const float*)(c.ws + WS_PMAXO) + ((size_t)l * 64 + c.lane) * DM + n : (const float*)(c.ws + WS_PMAX) + ((size_t)l * 64 + c.lane) * NI8 + n;
    r.swp = wo ? (float*)(c.ws + WS_SWO) + l * DM + n : (float*)(c.ws + WS_SW) + l * NI8 + n;
    r.src = (wo ? (const bf16*)(c.ws + WS_WOUT + l * WOUT_L) : (const bf16*)(c.ws + WS_WIN + l * WIN_L)) + (size_t)col * DM;
    r.dst = (wo ? c.ws + WS_W8O + l * W8O_L : c.ws + WS_W8 + l * W8_L) + (size_t)n * DM;
    return r; }
__device__ __forceinline__ void quantize_w8(const Ctx& c, int l, int nn0, int nn1) {
#pragma unroll 1
    for (int nnA = nn0 + c.gw; nnA < nn1; nnA += 2 * c.NGW) {
        const bool hasB = nnA + c.NGW < nn1;
        const QRow ra = qrow(c, l, nnA), rb = qrow(c, l, hasB ? nnA + c.NGW : nnA);
        float mxa = *ra.pm, mxb = *rb.pm;
        v4u ia[8], ib[8];
#pragma unroll
        for (int j = 0; j < 8; ++j) { ia[j] = *(const v4u*)(ra.src + j * 512 + c.lane * 8); ib[j] = *(const v4u*)(rb.src + j * 512 + c.lane * 8); }
        mxa = wave_max(mxa); mxb = wave_max(mxb);
        const float sca = mxa > 0.f ? mxa * (1.0f / 127.0f) : 1.0f, inva = 1.0f / sca, scb = mxb > 0.f ? mxb * (1.0f / 127.0f) : 1.0f, invb = 1.0f / scb;
        if (c.lane == 0) { __hip_atomic_store(ra.swp, sca, __ATOMIC_RELAXED, __HIP_MEMORY_SCOPE_AGENT);
            if (hasB) __hip_atomic_store(rb.swp, scb, __ATOMIC_RELAXED, __HIP_MEMORY_SCOPE_AGENT); }
#pragma unroll
        for (int h = 0; h < 2; ++h) { if (h == 1 && !hasB) break;
#pragma unroll
            for (int j = 0; j < 8; ++j) { float f[8]; unpack8(h ? ib[j] : ia[j], f); int q[8]; const float inv = h ? invb : inva;
#pragma unroll
                for (int e = 0; e < 8; ++e) q[e] = __float2int_rn(f[e] * inv);
                v2u w; w.x = (unsigned)(q[0] & 255) | ((unsigned)(q[1] & 255) << 8) | ((unsigned)(q[2] & 255) << 16) | ((unsigned)(q[3] & 255) << 24);
                w.y = (unsigned)(q[4] & 255) | ((unsigned)(q[5] & 255) << 8) | ((unsigned)(q[6] & 255) << 16) | ((unsigned)(q[7] & 255) << 24);
                *(v2u*)((h ? rb.dst : ra.dst) + j * 512 + c.lane * 8) = w; } }
    }
}
__device__ __forceinline__ void modp_items(const Ctx& c, int l, int w, int nw) {
    const float* c_in = c.ap->in[1]; const float* cctx_in = c.ap->in[3]; const float* w_ada = c.ap->in[4];
    float* modp = (float*)(c.ws + WS_MODP); const int lane = c.lane;
    for (int r = w; r < NKC * 48; r += nw) {
        const int kc = r / 48, cb = r % 48;
        const float* W = w_ada + ((size_t)l * DM + kc * 64) * 12288 + cb * 256 + lane * 4;
        f32x4 a0 = {0.f, 0.f, 0.f, 0.f}, a1 = a0, a2 = a0;
        const int cvi0 = __builtin_bit_cast(int, silu_f(c_in[kc * 64 + lane])), cvi1 = __builtin_bit_cast(int, silu_f(c_in[DM + kc * 64 + lane])), cvi2 = __builtin_bit_cast(int, silu_f(cctx_in[kc * 64 + lane]));
#pragma unroll 1
        for (int k0 = 0; k0 < 64; k0 += 16) { f32x4 wv[16];
#pragma unroll
            for (int j = 0; j < 16; ++j) wv[j] = __builtin_nontemporal_load((const f32x4*)(W + (size_t)(k0 + j) * 12288));
#pragma unroll
            for (int j = 0; j < 16; ++j) { const float s0 = __builtin_bit_cast(float, __builtin_amdgcn_readlane(cvi0, k0 + j)), s1 = __builtin_bit_cast(float, __builtin_amdgcn_readlane(cvi1, k0 + j)), s2 = __builtin_bit_cast(float, __builtin_amdgcn_readlane(cvi2, k0 + j));
                a0 += wv[j] * s0; a1 += wv[j] * s1; a2 += wv[j] * s2; } }
        float* o = modp + ((size_t)(l * NKC + kc) * 3) * 12288 + cb * 256 + lane * 4;
        *(f32x4*)o = a0; *(f32x4*)(o + 12288) = a1; *(f32x4*)(o + 2 * 12288) = a2;
    }
}
__device__ __forceinline__ void modv_reduce(const Ctx& c, int l) {
    const float* b_ada = c.ap->in[5]; float* modv = (float*)(c.ws + WS_MOD); const float* modp = (const float*)(c.ws + WS_MODP);
    for (int r = c.gw * 64 + c.lane; r < 3 * 12288; r += c.NGW * 64) { const int w = r / 12288, col = r % 12288;
        const float* mp = modp + ((size_t)(l * NKC) * 3 + w) * 12288 + col;
        float s = b_ada[l * 12288 + col];
#pragma unroll
        for (int h = 0; h < NKC / 32; ++h) { float v[32];
#pragma unroll
            for (int k = 0; k < 32; ++k) v[k] = mp[(size_t)(h * 32 + k) * 3 * 12288];
#pragma unroll
            for (int k = 0; k < 32; ++k) s += v[k]; }
        modv[l * 36864 + r] = s; }
}
__device__ __forceinline__ void direct_w8_block(const Ctx& c, LAS unsigned char* lds, const float* Wsrc, const int INC_, int srccol, unsigned char* dstrow, float* swdst) {
    const int lane = c.lane, wave = c.wave, kr = lane >> 3, nc = lane & 7;
    const float* W = Wsrc + (size_t)(512 * wave + 8 * kr) * INC_ + srccol + 4 * nc;
    LAS float* pm = (LAS float*)(lds + RING_BYTES + 2048);
    LAS unsigned char* hl = lds + RING_OFF + wave * 16384 + lane * 16;
    f32x4 mx = {0.f, 0.f, 0.f, 0.f};
    unsigned held[4][4][4];
#pragma unroll
    for (int t = 0; t < 8; ++t) { f32x4 v[8]; const float* Wt = W + (size_t)(t * 64) * INC_; asm volatile("" : "+v"(Wt));
#pragma unroll
        for (int e = 0; e < 8; ++e) v[e] = __builtin_nontemporal_load((const f32x4*)(Wt + (size_t)e * INC_));
#pragma unroll
        for (int j = 0; j < 4; ++j) {
#pragma unroll
            for (int e = 0; e < 8; ++e) mx[j] = fmaxf(mx[j], fabsf(v[e][j]));
            v4u pk; pk.x = pk2(v[0][j], v[1][j]); pk.y = pk2(v[2][j], v[3][j]); pk.z = pk2(v[4][j], v[5][j]); pk.w = pk2(v[6][j], v[7][j]);
            if (t < 4) { held[t & 3][j][0] = pk.x; held[t & 3][j][1] = pk.y; held[t & 3][j][2] = pk.z; held[t & 3][j][3] = pk.w; }
            else *(LAS v4u*)(hl + ((t - 4) * 4 + j) * 1024) = pk; }
        if ((t & 3) == 3) { asm volatile("" ::: "memory"); __builtin_amdgcn_sched_barrier(0); } }
#pragma unroll
    for (int j = 0; j < 4; ++j) { float m = mx[j]; m = fmaxf(m, __shfl_xor(m, 8)); m = fmaxf(m, __shfl_xor(m, 16)); m = fmaxf(m, __shfl_xor(m, 32)); mx[j] = m; }
    if (kr == 0) *(LAS f32x4*)(pm + wave * 32 + 4 * nc) = mx;
    __syncthreads();
    f32x4 cm = *(const LAS f32x4*)(pm + 4 * nc);
#pragma unroll
    for (int w2 = 1; w2 < 8; ++w2) { const f32x4 o = *(const LAS f32x4*)(pm + w2 * 32 + 4 * nc);
#pragma unroll
        for (int j = 0; j < 4; ++j) cm[j] = fmaxf(cm[j], o[j]); }
    __syncthreads();
    f32x4 sc, inv;
#pragma unroll
    for (int j = 0; j < 4; ++j) { sc[j] = cm[j] > 0.f ? cm[j] * (1.0f / 127.0f) : 1.0f; inv[j] = 1.0f / sc[j]; }
    if (wave == 0 && kr == 0) *(f32x4*)(swdst + 4 * nc) = sc;
    unsigned char* dst = dstrow + (size_t)(4 * nc) * DM + 512 * wave + 8 * kr;
#pragma unroll
    for (int t = 0; t < 8; ++t) { unsigned char* dt = dst + t * 64; asm volatile("" : "+v"(dt));
#pragma unroll
        for (int j = 0; j < 4; ++j) { v4u pk;
            if (t < 4) { pk.x = held[t & 3][j][0]; pk.y = held[t & 3][j][1]; pk.z = held[t & 3][j][2]; pk.w = held[t & 3][j][3]; }
            else pk = *(const LAS v4u*)(hl + ((t - 4) * 4 + j) * 1024);
            int qi[8];
#pragma unroll
            for (int pr = 0; pr < 4; ++pr) { qi[2 * pr] = __float2int_rn(bflo(pk[pr]) * inv[j]); qi[2 * pr + 1] = __float2int_rn(bfhi(pk[pr]) * inv[j]); }
            v2u w; w.x = (unsigned)(qi[0] & 255) | ((unsigned)(qi[1] & 255) << 8) | ((unsigned)(qi[2] & 255) << 16) | ((unsigned)(qi[3] & 255) << 24);
            w.y = (unsigned)(qi[4] & 255) | ((unsigned)(qi[5] & 255) << 8) | ((unsigned)(qi[6] & 255) << 16) | ((unsigned)(qi[7] & 255) << 24);
            *(v2u*)(dt + (size_t)j * DM) = w; } }
}
__device__ __forceinline__ void direct_win_block(const Ctx& c, LAS unsigned char* lds, int l, int cb) {
    const int n8 = 32 * cb; direct_w8_block(c, lds, c.ap->in[6] + (size_t)l * DM * INC, INC, n8 < C_BF0 ? n8 : n8 + (C_BF1 - C_BF0), c.ws + WS_W8 + l * W8_L + (size_t)n8 * DM, (float*)(c.ws + WS_SW) + l * NI8 + n8); }
__device__ __forceinline__ void direct_wout_block(const Ctx& c, LAS unsigned char* lds, int l, int cb) {
    const int n8 = 32 * cb; direct_w8_block(c, lds, c.ap->in[17] + (size_t)l * DM * DM, DM, n8, c.ws + WS_W8O + l * W8O_L + (size_t)n8 * DM, (float*)(c.ws + WS_SWO) + l * DM + n8); }
__device__ __forceinline__ void bf16_tiles(const Ctx& c, int l, int j0, int j1, int w, int nw) {
    unsigned char* ws = c.ws; const int lane = c.lane; constexpr int NBT = (C_BF1 - C_BF0) / 64;
#pragma unroll 1
    for (int j = j0 + w; j < j1; j += nw) {
        if (j < 64 * NBT) { p0_transpose_item(c.ap->in[6] + (size_t)l * DM * INC, DM, INC, (bf16*)(ws + WS_WIN + l * WIN_L), (j / NBT) * (INC / 64) + C_BF0 / 64 + j % NBT, lane, nullptr); continue; }
        int r = j - 64 * NBT;
        if (r < 2048) { p0_transpose_item(c.ap->in[14] + (size_t)l * ATTN_W * DM, ATTN_W, DM, (bf16*)(ws + WS_WBR + l * WBR_L), r, lane, nullptr, 1, DM, 0); continue; } r -= 2048;
        if (r < 1024) { p0_transpose_item(c.ap->in[15] + (size_t)l * CONV_W * DM, CONV_W, DM, (bf16*)(ws + WS_WBR + l * WBR_L), r, lane, nullptr, 1, DM, ATTN_W); continue; } r -= 1024;
        p0_transpose_item(c.ap->in[16] + (size_t)l * GM_W * DM, GM_W, DM, (bf16*)(ws + WS_WBR + l * WBR_L), r, lane, nullptr, 1, DM, ATTN_W + CONV_W);
    }
}
__device__ __forceinline__ void phase_tail_transposes(LAS unsigned char* lds, int part, int wv) {
    const Ctx c = fresh_ctx(wv);
    constexpr int NB1 = NI8 / 32, NBO = DM / 32, NT0 = 128;
    if (part == 0) {
        if (c.G != 256) { bf16_tiles(c, 0, 7168, 11264, c.gw, c.NGW); for (int cb = c.vcu; cb < NT0; cb += c.G) direct_win_block(c, lds, 1, cb); return; }
        if (c.vcu < 192) return;
        bf16_tiles(c, 0, 7168, 11264, (c.vcu - 192) * NWAVES + c.wave, 64 * NWAVES);
        for (int cb = c.vcu - 192; cb < NT0; cb += 64) direct_win_block(c, lds, 1, cb);
        return; }
    const int nbusy = (34 * 16) % c.G;
    if (c.vcu < nbusy) return;
    const int idx = c.vcu - nbusy, nidle = c.G - nbusy, w = idx * NWAVES + c.wave, nw = nidle * NWAVES;
    if (part == 1) {
        for (int cb = idx; cb < NBO; cb += nidle) direct_wout_block(c, lds, 0, cb);
        modp_items(c, 1, w, nw);
        const int rot = nidle > NBO ? nidle - NBO : 0;
        for (int k = (idx + rot) % nidle; k < NB1 - NT0; k += nidle) direct_win_block(c, lds, 1, NT0 + k); }
    else {
        for (int cb = idx; cb < NBO; cb += nidle) direct_wout_block(c, lds, 1, cb);
        bf16_tiles(c, 1, 0, 11264, w, nw); }
}
__device__ __forceinline__ void phase_p0(LAS unsigned char* lds, int wv) {
    const Ctx c = fresh_ctx(wv); unsigned char* ws = c.ws; const int lane = c.lane;
    constexpr int NBLK = NI8 / 32;
    for (int cb = c.vcu; cb < NBLK; cb += c.G) direct_win_block(c, lds, 0, cb);
    const int nx = (NBLK > 2 * c.G && NBLK < 3 * c.G) ? NBLK - 2 * c.G : 0;
    if (c.vcu >= nx) { const int w = (c.vcu - nx) * NWAVES + c.wave, nw = (c.G - nx) * NWAVES;
        bf16_tiles(c, 0, 0, 64 * ((C_BF1 - C_BF0) / 64), w, nw);
        modp_items(c, 0, w, nw); }
    float* cosT = (float*)(ws + WS_ROPE); float* sinT = cosT + 2048;
    for (int i = c.gw * 64 + lane; i < 2048; i += c.NGW * 64) { const int pos = i >> 5, j = i & 31;
        double f = 1.0; for (int q = 0; q < j; ++q) f *= 0.7498942093324558273;
        float cs, sn; sincos_d((double)pos * f, cs, sn); cosT[i] = cs; sinT[i] = sn; }
}
__device__ __forceinline__ void phase_p1(int wv) {
    const Ctx c = fresh_ctx(wv);
    modv_reduce(c, 0);
}
__device__ __forceinline__ void store_u_row(const f32x4 (&u)[16], int row, int lane, bf16* Ub, unsigned char* U8, float* su) {
    float mx = 0.f;
#pragma unroll
    for (int j = 0; j < 16; ++j) { mx = fmaxf(mx, fmaxf(fmaxf(fabsf(u[j][0]), fabsf(u[j][1])), fmaxf(fabsf(u[j][2]), fabsf(u[j][3]))));
        v2u w; w.x = pk2(u[j][0], u[j][1]); w.y = pk2(u[j][2], u[j][3]); *(v2u*)(Ub + (size_t)row * DM + lane * 4 + 256 * j) = w; }
#pragma unroll
    for (int o = 1; o < 64; o <<= 1) mx = fmaxf(mx, __shfl_xor(mx, o));
    const float sc = mx > 0.f ? mx * (1.0f / 127.0f) : 1.0f, inv = 1.0f / sc;
    if (lane == 0) __hip_atomic_store(su + row, sc, __ATOMIC_RELAXED, __HIP_MEMORY_SCOPE_AGENT);
#pragma unroll
    for (int j = 0; j < 16; ++j) { const int q0 = __float2int_rn(u[j][0] * inv), q1 = __float2int_rn(u[j][1] * inv), q2 = __float2int_rn(u[j][2] * inv), q3 = __float2int_rn(u[j][3] * inv);
        *(unsigned*)(U8 + (size_t)row * DM + lane * 4 + 256 * j) = (unsigned)(q0 & 255) | ((unsigned)(q1 & 255) << 8) | ((unsigned)(q2 & 255) << 16) | ((unsigned)(q3 & 255) << 24); }
}
__device__ __forceinline__ void phase_p2(int wv) {
    const Ctx c = fresh_ctx(wv); const float* x_in = c.ap->in[0]; const float* ctx_in = c.ap->in[2];
    const float* modv = (const float*)(c.ws + WS_MOD); bf16* Ub = (bf16*)(c.ws + WS_U); const int lane = c.lane;
#pragma unroll 2
    for (int row = c.gw; row < MT; row += c.NGW) {
        const float* src = row < NLAT ? x_in + (size_t)row * DM : ctx_in + (size_t)(row - NLAT) * DM;
        const float* mr = modv + (row < SEQ ? 0 : (row < NLAT ? 1 : 2)) * 12288;
        f32x4 u[16];
#pragma unroll
        for (int j = 0; j < 16; ++j) { const int col = lane * 4 + 256 * j;
            const f32x4 xv = *(const f32x4*)(src + col), sh = *(const f32x4*)(mr + col), sc = *(const f32x4*)(mr + DM + col);
            u[j] = xv * (sc + 1.0f) + sh; }
        store_u_row(u, row, lane, Ub, c.ws + WS_U8, (float*)(c.ws + WS_SU));
    }
}
__device__ __forceinline__ void phase_g1a(LAS unsigned char* lds, int l, int wv) {
    const Ctx c = fresh_ctx(wv); const bool last = (l == DEPTH - 1);
    pg8::Gemm g{(const bf16*)(c.ws + WS_U), (const bf16*)(c.ws + WS_WIN + l * WIN_L) + (size_t)C_BF0 * DM, DM, DM, DM};
    pg8::Order S; S.init(last ? 32 : 34, (C_BF1 - C_BF0) / 256, c.G, c.vcu, 0); S.noremap = 1;
    if (last && c.G == 256) { S.seg = 1; S.sn0 = 2; S.sw0 = 256; S.sn1 = 1; S.sw1 = 248; S.sn2 = 1; S.sw2 = 136; }
    pg8::EpiBf16 E{(bf16*)(c.ws + WS_P) + C_BF0, INC, 1 << 30};
    pg8::gemm_phase<pg8::EpiBf16, pg8::Order, true, true, false>(lds + RING_OFF, g, S, E, c.tid);
}
__device__ __forceinline__ void phase_g1b(LAS unsigned char* lds, int l, int wv) {
    const Ctx c = fresh_ctx(wv); const bool last = (l == DEPTH - 1);
    pg8::Gemm g{(const bf16*)(c.ws + WS_U8), (const bf16*)(c.ws + WS_W8 + l * W8_L), DM / 2, DM / 2, DM / 2};
    const int nA = (last ? 32 : 34) * ((C_BF1 - C_BF0) / 256), nlong = nA % c.G, n3 = nlong ? c.G - nlong : c.G;
    pg8::Order S; S.init(last ? 32 : 34, NI8 / 256, c.G, (c.vcu + n3) % c.G, last ? 8 : 0, n3); S.noremap = 1;
    if (last && c.G == 256) { S.c = c.G - 1 - c.vcu; S.seg = 1; S.sn0 = 8; S.sw0 = 256; S.sn1 = 1; S.sw1 = 120; S.sn2 = 2; S.sw2 = 8; }
    pg8::EpiGateI8 E{(bf16*)(c.ws + WS_P), INC, (const float*)(c.ws + WS_SU), (const float*)(c.ws + WS_SW) + l * NI8};
    pg8::gemm_phase<pg8::EpiGateI8, pg8::Order, true, true, true>(lds + RING_OFF, g, S, E, c.tid);
}
__device__ __forceinline__ v4u norm_rope8b(v4u in, const f32x4 g0, const f32x4 g1, bool rope, bool first, const f32x4 c0, const f32x4 c1, const f32x4 s0, const f32x4 s1) {
    float f[8]; unpack8(in, f);
    float ss = 0.f;
#pragma unroll
    for (int e = 0; e < 8; ++e) ss += f[e] * f[e];
    ss = sum16(ss);
    const float rstd = 1.0f / sqrtf(ss * (1.0f / 128.0f) + EPS);
    float y[8];
#pragma unroll
    for (int e = 0; e < 4; ++e) { y[e] = f[e] * rstd * g0[e]; y[4 + e] = f[4 + e] * rstd * g1[e]; }
    if (rope) {
#pragma unroll
        for (int e = 0; e < 8; ++e) { const float py = lane_xor4(y[e]); const float cs = e < 4 ? c0[e & 3] : c1[e & 3], sn = e < 4 ? s0[e & 3] : s1[e & 3];
            y[e] = first ? (y[e] * cs - py * sn) : (y[e] * cs + py * sn); }
    }
    return pack8(y);
}
__device__ __forceinline__ void phase_t1_rows(int l, int wv) {
    const Ctx c = fresh_ctx(wv); const bool last = (l == DEPTH - 1); const int lane = c.lane;
    const float* qn = c.ap->in[7] + l * HD; const float* kn = c.ap->in[8] + l * HD; const float* cw = c.ap->in[9] + l * 3 * CONV_W;
    const float* cosT = (const float*)(c.ws + WS_ROPE); const float* sinT = cosT + 2048;
    const bf16* Pb = (const bf16*)(c.ws + WS_P); bf16* Qb = (bf16*)(c.ws + WS_Q); bf16* Kb = (bf16*)(c.ws + WS_K); bf16* Vb = (bf16*)(c.ws + WS_V); bf16* Yb = (bf16*)(c.ws + WS_Y);
    const int hl = lane & 15, j0 = (hl & 3) * 8; const bool first = (hl & 7) < 4;
    const f32x4 qg0 = *(const f32x4*)(qn + hl * 8), qg1 = *(const f32x4*)(qn + hl * 8 + 4), kg0 = *(const f32x4*)(kn + hl * 8), kg1 = *(const f32x4*)(kn + hl * 8 + 4);
    const int ngm = (last ? NLAT : MT) / 128 * 4, nx = (ngm > c.G && ngm < 2 * c.G) ? ngm - c.G : 0;
    if (c.vcu < nx) return;
    const int gw0 = (c.vcu - nx) * NWAVES + c.wave, ngw = (c.G - nx) * NWAVES;
#pragma unroll 1
    for (int row = gw0; row < MT; row += ngw) {
        const bool isctx = row >= NLAT;
        const int b = isctx ? ((row - NLAT) >> 8) : (row >> 12), t = isctx ? ((row - NLAT) & 255) : (row & 4095);
        const bf16* Prow = Pb + (size_t)row * INC;
        const size_t krow = (size_t)b * SKV + (isctx ? t : CTXL + t);
        const int pos = (hl >> 3) ? (t & 63) : (t >> 6);
        const f32x4 c0 = *(const f32x4*)(cosT + pos * 32 + j0), c1 = *(const f32x4*)(cosT + pos * 32 + j0 + 4);
        const f32x4 s0 = *(const f32x4*)(sinT + pos * 32 + j0), s1 = *(const f32x4*)(sinT + pos * 32 + j0 + 4);
        const v4u kin = *(const v4u*)(Prow + C_K + lane * 8), vin = *(const v4u*)(Prow + C_V + lane * 8);
        if (isctx && last) {
            *(v4u*)(Kb + krow * KV_W + lane * 8) = norm_rope8b(kin, kg0, kg1, false, first, c0, c1, s0, s1);
            *(v4u*)(Vb + krow * KV_W + lane * 8) = vin;
            continue;
        }
        v4u qin[4];
#pragma unroll
        for (int ch = 0; ch < 4; ++ch) qin[ch] = *(const v4u*)(Prow + C_Q + ch * 512 + lane * 8);
        const int seqlen = isctx ? CTXL : SEQ;
        const bool hasm = t > 0, hasp = t < seqlen - 1;
        const bf16* Pm = hasm ? Prow - INC : Prow; const bf16* Pp = hasp ? Prow + INC : Prow;
        const float m0 = hasm ? 1.f : 0.f, m2 = hasp ? 1.f : 0.f;
        v4u am[2], bm[2], a0[2], b0[2], ap[2], bp[2], cbw[2], cgw[2]; f32x4 w[2][6];
#pragma unroll
        for (int ch = 0; ch < 2; ++ch) { const int cc = ch * 512 + lane * 8;
            am[ch] = *(const v4u*)(Pm + C_CC + cc); bm[ch] = *(const v4u*)(Pm + C_CH + cc);
            a0[ch] = *(const v4u*)(Prow + C_CC + cc); b0[ch] = *(const v4u*)(Prow + C_CH + cc);
            ap[ch] = *(const v4u*)(Pp + C_CC + cc); bp[ch] = *(const v4u*)(Pp + C_CH + cc);
            cbw[ch] = *(const v4u*)(Prow + C_CB + cc); cgw[ch] = *(const v4u*)(Prow + C_CG + cc);
#pragma unroll
            for (int tp = 0; tp < 3; ++tp) { w[ch][2 * tp] = *(const f32x4*)(cw + tp * CONV_W + cc); w[ch][2 * tp + 1] = *(const f32x4*)(cw + tp * CONV_W + cc + 4); } }
#pragma unroll
        for (int ch = 0; ch < 4; ++ch) *(v4u*)(Qb + (size_t)row * ATTN_W + ch * 512 + lane * 8) = norm_rope8b(qin[ch], qg0, qg1, !isctx, first, c0, c1, s0, s1);
        *(v4u*)(Kb + krow * KV_W + lane * 8) = norm_rope8b(kin, kg0, kg1, !isctx, first, c0, c1, s0, s1);
        *(v4u*)(Vb + krow * KV_W + lane * 8) = vin;
#pragma unroll
        for (int ch = 0; ch < 2; ++ch) { const int cc = ch * 512 + lane * 8;
            float fa[8], fb[8], z0[8], z1[8], z2[8], cbv[8], cgv[8], y[8];
            unpack8(am[ch], fa); unpack8(bm[ch], fb);
#pragma unroll
            for (int e = 0; e < 8; ++e) z0[e] = fa[e] * fb[e] * m0;
            unpack8(a0[ch], fa); unpack8(b0[ch], fb);
#pragma unroll
            for (int e = 0; e < 8; ++e) z1[e] = fa[e] * fb[e];
            unpack8(ap[ch], fa); unpack8(bp[ch], fb);
#pragma unroll
            for (int e = 0; e < 8; ++e) z2[e] = fa[e] * fb[e] * m2;
            unpack8(cbw[ch], cbv); unpack8(cgw[ch], cgv);
#pragma unroll
            for (int e = 0; e < 8; ++e) { const float w0 = w[ch][e >> 2][e & 3], w1 = w[ch][2 + (e >> 2)][e & 3], w2 = w[ch][4 + (e >> 2)][e & 3];
                y[e] = cbv[e] * (w0 * z0[e] + w1 * z1[e] + w2 * z2[e]) * silu_f(cgv[e]); }
            *(v4u*)(Yb + (size_t)row * DM + ATTN_W + cc) = pack8(y); }
    }
}
struct GmOps { f32x4 wr[8]; v4u uw[4], gw[4], vs[4]; f32x4 ga0, ga1, be0, be1; float bias; };
struct GmCtx { int l, r0, wave, fr, fq; const bf16* Pb; bf16* Yb; const float* lng; const float* lnb; const float* gm_ws; const float* gm_b; };
__device__ __forceinline__ void gm_load(GmOps& o, const GmCtx& G, int g) {
    const float* Wsp = G.gm_ws + ((size_t)(G.l * 8 + g) * 128 + G.wave * 16 + G.fr) * 128 + G.fq * 8;
#pragma unroll
    for (int kk = 0; kk < 4; ++kk) { o.wr[2 * kk] = *(const f32x4*)(Wsp + kk * 32); o.wr[2 * kk + 1] = *(const f32x4*)(Wsp + kk * 32 + 4); }
    const size_t orow = (size_t)(G.r0 + G.wave * 16 + G.fr);
#pragma unroll
    for (int j = 0; j < 4; ++j) { const int d = g * 128 + 32 * G.fq + 8 * j; o.uw[j] = *(const v4u*)(G.Pb + orow * INC + C_GU + d); o.gw[j] = *(const v4u*)(G.Pb + orow * INC + C_GG + d); }
    o.bias = G.gm_b[(G.l * 8 + g) * 128 + G.wave * 16 + G.fr];
    const int gc = g * 128 + G.fr * 8;
    o.ga0 = *(const f32x4*)(G.lng + gc); o.ga1 = *(const f32x4*)(G.lng + gc + 4); o.be0 = *(const f32x4*)(G.lnb + gc); o.be1 = *(const f32x4*)(G.lnb + gc + 4);
#pragma unroll
    for (int bt = 0; bt < 4; ++bt) o.vs[bt] = *(const v4u*)(G.Pb + (size_t)(G.r0 + G.wave * 16 + bt * 4 + G.fq) * INC + C_GV + gc);
}
__device__ __forceinline__ void gm_norm(const GmOps& o, const GmCtx& G, const float (&mean)[4], const float (&rstd)[4], LAS bf16* vnT) {
#pragma unroll
    for (int bt = 0; bt < 4; ++bt) { const int rr = G.wave * 16 + bt * 4 + G.fq; float f[8]; unpack8(o.vs[bt], f);
#pragma unroll
        for (int e = 0; e < 8; ++e) { const float gg = e < 4 ? o.ga0[e & 3] : o.ga1[e & 3], bb = e < 4 ? o.be0[e & 3] : o.be1[e & 3];
            vnT[(e * 16 + G.fr) * 136 + rr] = (bf16)f2bf((f[e] - mean[bt]) * rstd[bt] * gg + bb); } }
}
__device__ __forceinline__ void gm_mma_epi(const GmOps& o, const GmCtx& G, int g, const LAS bf16* vnT) {
    const int fr = G.fr, fq = G.fq;
    f32x4 acc[8];
#pragma unroll
    for (int nb = 0; nb < 8; ++nb) acc[nb] = (f32x4){0.f, 0.f, 0.f, 0.f};
#pragma unroll
    for (int kk = 0; kk < 4; ++kk) {
        const f32x4 wa = o.wr[2 * kk], wb = o.wr[2 * kk + 1];
        v4u aw; aw.x = pk2(wa[0], wa[1]); aw.y = pk2(wa[2], wa[3]); aw.z = pk2(wb[0], wb[1]); aw.w = pk2(wb[2], wb[3]);
        const bf16x8 wf = __builtin_bit_cast(bf16x8, aw);
#pragma unroll
        for (int nb = 0; nb < 8; ++nb) { const bf16x8 vf = *(const LAS bf16x8*)(vnT + (nb * 16 + fr) * 136 + kk * 32 + fq * 8);
            acc[nb] = __builtin_amdgcn_mfma_f32_16x16x32_bf16(vf, wf, acc[nb], 0, 0, 0); }
    }
    const size_t orow = (size_t)(G.r0 + G.wave * 16 + fr);
#pragma unroll
    for (int j = 0; j < 4; ++j) { const int d = g * 128 + 32 * fq + 8 * j;
        float uf[8], gf[8], y[8]; unpack8(o.uw[j], uf); unpack8(o.gw[j], gf);
#pragma unroll
        for (int nb = 0; nb < 8; ++nb) y[nb] = uf[nb] * (acc[nb][j] + o.bias) * silu_f(gf[nb]);
        *(v4u*)(G.Yb + orow * DM + ATTN_W + CONV_W + d) = pack8(y); }
}
__device__ __forceinline__ void phase_t1_gmlp(LAS unsigned char* lds, int l, int wv) {
    const Ctx c = fresh_ctx(wv); const bool last = (l == DEPTH - 1); const int lane = c.lane, wave = c.wave;
    GmCtx G; G.l = l; G.wave = wave; G.fr = lane & 15; G.fq = lane >> 4; G.Pb = (const bf16*)(c.ws + WS_P); G.Yb = (bf16*)(c.ws + WS_Y);
    G.lng = c.ap->in[10] + l * GM_W; G.lnb = c.ap->in[11] + l * GM_W; G.gm_ws = c.ap->in[12]; G.gm_b = c.ap->in[13];
    const int nunits = (last ? NLAT : MT) / 128 * 4;
    LAS bf16* vnT0 = (LAS bf16*)(lds + RING_OFF); LAS bf16* vnT1 = vnT0 + 128 * 136;
    const int fr = G.fr, fq = G.fq;
#pragma unroll 1
    for (int uu = c.vcu; uu < nunits; uu += c.G) {
        const int cch = uu >> 2, gp = uu & 3; G.r0 = cch * 128;
        GmOps A; gm_load(A, G, 2 * gp);
        float mean[4], rstd[4];
#pragma unroll
        for (int hb = 0; hb < 2; ++hb) {
            v4u rv[2][8];
#pragma unroll
            for (int bt = 0; bt < 2; ++bt) { const bf16* Pv = G.Pb + (size_t)(G.r0 + wave * 16 + (hb * 2 + bt) * 4 + fq) * INC + C_GV;
#pragma unroll
                for (int j = 0; j < 8; ++j) rv[bt][j] = *(const v4u*)(Pv + j * 128 + fr * 8); }
#pragma unroll
            for (int bt = 0; bt < 2; ++bt) {
                float sm = 0.f;
#pragma unroll
                for (int j = 0; j < 8; ++j) { float f[8]; unpack8(rv[bt][j], f);
#pragma unroll
                    for (int e = 0; e < 8; ++e) sm += f[e]; }
                const float mn = sum16(sm) * (1.0f / 1024.0f);
                float q = 0.f;
#pragma unroll
                for (int j = 0; j < 8; ++j) { float f[8]; unpack8(rv[bt][j], f);
#pragma unroll
                    for (int e = 0; e < 8; ++e) { const float d0 = f[e] - mn; q += d0 * d0; } }
                mean[hb * 2 + bt] = mn; rstd[hb * 2 + bt] = 1.0f / sqrtf(sum16(q) * (1.0f / 1024.0f) + EPS); }
        }
        gm_norm(A, G, mean, rstd, vnT0);
        GmOps B; gm_load(B, G, 2 * gp + 1);
        __syncthreads();
        gm_mma_epi(A, G, 2 * gp, vnT0);
        gm_norm(B, G, mean, rstd, vnT1);
        __syncthreads();
        gm_mma_epi(B, G, 2 * gp + 1, vnT1);
    }
    __syncthreads();
}
__device__ __forceinline__ void phase_attn(char* lds_generic, int l, int wv) {
    const Ctx c = fresh_ctx(wv); const bool last = (l == DEPTH - 1);
    const bf16* Pb = (const bf16*)(c.ws + WS_P); const bf16* Qb = (const bf16*)(c.ws + WS_Q); const bf16* Kb = (const bf16*)(c.ws + WS_K); const bf16* Vb = (const bf16*)(c.ws + WS_V); bf16* Yb = (bf16*)(c.ws + WS_Y);
    const int NU = 512 + (last ? 0 : 32);
    for (int i = c.vcu; i < NU; i += c.G) {
        int b, h, row0, seq;
        if (i < 512) { b = i >> 8; h = ((i >> 6) & 3) * 4 + ((i >> 4) & 3); row0 = b * SEQ + (i & 15) * 256; seq = SKV; }
        else { const int e = i - 512; b = e >> 4; h = e & 15; row0 = NLAT + b * CTXL; seq = CTXL; }
        const int kvh = h >> 2;
        int tfresh = c.tid; asm volatile("" : "+v"(tfresh));
        attn::attn_dense_body((const attn::bf16*)(Qb + (size_t)row0 * ATTN_W + h * HD), (const attn::bf16*)(Kb + (size_t)b * SKV * KV_W + kvh * HD),
                              (const attn::bf16*)(Vb + (size_t)b * SKV * KV_W + kvh * HD), Pb + (size_t)row0 * INC + C_AG + h * HD, Yb + (size_t)row0 * DM + h * HD, seq, lds_generic + RING_OFF, tfresh);
    }
}
__device__ __forceinline__ void phase_g2(LAS unsigned char* lds, int l, int wv) {
    const Ctx c = fresh_ctx(wv); const bool last = (l == DEPTH - 1);
    pg8::Order S; S.init(last ? 32 : 34, DM / 256, c.G, c.vcu, 0); S.panel = 1;
    pg8::Gemm g{(const bf16*)(c.ws + WS_Y), (const bf16*)(c.ws + WS_WBR + l * WBR_L), DM, DM, DM};
    pg8::EpiMerge E{(const bf16*)(c.ws + WS_P) + C_MG, INC, c.ws + WS_MG8, DM, (unsigned*)(c.ws + WS_CTL + CTL_ROWMAX) + l * MT,
                    (unsigned*)(c.ws + WS_CTL + CTL_PCNT) + l * 64 * 64, 16u * 8u, (float*)(c.ws + WS_SM), (unsigned*)(c.ws + WS_CTL) + 2};
    pg8::gemm_phase<pg8::EpiMerge, pg8::Order, true, true, false>(lds + RING_OFF, g, S, E, c.tid);
}
__device__ __forceinline__ void phase_mq(int l, int wv) {
    const Ctx c = fresh_ctx(wv);
    if (l == 0) modv_reduce(c, 1);
}
__device__ __forceinline__ void phase_g3(LAS unsigned char* lds, int l, int wv) {
    const Ctx c = fresh_ctx(wv); const bool last = (l == DEPTH - 1);
    const bf16* XC = (const bf16*)(c.ws + WS_XC);
    pg8::Gemm g{(const bf16*)(c.ws + WS_MG8), (const bf16*)(c.ws + WS_W8O + l * W8O_L), DM / 2, DM / 2, DM / 2};
    pg8::Order S; S.init(last ? 32 : 34, DM / 256, c.G, c.vcu, 0); S.panel = 1;
    if (last) { pg8::EpiResLnI8<true, true> E{c.ws, l, XC, XC + (size_t)NLAT * DM, c.ap->in[18] + l * DM, c.ap->in[19] + l * DM, c.ap->out};
        pg8::gemm_phase<pg8::EpiResLnI8<true, true>, pg8::Order, true, true, true>(lds + RING_OFF, g, S, E, c.tid); }
    else { pg8::EpiResLnI8<false, false> E{c.ws, l, c.ap->in[0], c.ap->in[2], c.ap->in[18] + l * DM, c.ap->in[19] + l * DM, nullptr};
        pg8::gemm_phase<pg8::EpiResLnI8<false, false>, pg8::Order, true, true, true>(lds + RING_OFF, g, S, E, c.tid); }
}
__device__ __forceinline__ void phase_q1(int wv) {
    const Ctx c = fresh_ctx(wv);
    quantize_w8(c, 1, 0, NI8 + DM);
}
__global__ void __launch_bounds__(NWAVES * 64, 2) mega_fwd(Args args) {
    extern __shared__ __attribute__((aligned(16))) unsigned char lds_raw[];
    LAS unsigned char* lds = (LAS unsigned char*)lds_raw;
    volatile LAS unsigned* MISC = (volatile LAS unsigned*)(lds + MISC_OFF);
    for (int u = threadIdx.x; u < (LDS_BYTES - LDSCTL_OFF) / 4; u += NWAVES * 64) ((LAS unsigned*)(lds + LDSCTL_OFF))[u] = 0u;
    __syncthreads();
    (void)xcd_barrier_post((unsigned*)(args.ws + WS_CTL) + CW_BAR, MISC + 8);
    const int wv = __builtin_amdgcn_readfirstlane((int)threadIdx.x >> 6);
#define GRID_BAR() do { ArgsP ap_ = (ArgsP)__builtin_amdgcn_kernarg_segment_ptr(); asm volatile("" : "+s"(ap_)); XcdBarrier b_; b_.bar = (unsigned*)(ap_->ws + WS_CTL) + CW_BAR; b_.x = xb_xcc_id(); \
        b_.st = (volatile LAS unsigned*)(lds + MISC_OFF) + 8; xcd_barrier(b_, wv == 0 && lane_id_fresh() == 0); } while (0)
    phase_p0(lds, wv);
    GRID_BAR();
    phase_p1(wv);
    GRID_BAR();
    phase_p2(wv);
    GRID_BAR();
#pragma nounroll
    for (int l = 0; l < DEPTH; ++l) {
        phase_g1a(lds, l, wv);
        phase_g1b(lds, l, wv);
        if (l == 0) phase_tail_transposes(lds, 0, wv);
        GRID_BAR();
        phase_t1_rows(l, wv);
        phase_t1_gmlp(lds, l, wv);
        GRID_BAR();
        phase_attn((char*)lds_raw, l, wv);
        GRID_BAR();
        phase_g2(lds, l, wv);
        if (l == 0) phase_tail_transposes(lds, 1, wv);
        GRID_BAR();
        if (l == 0) { phase_mq(l, wv); GRID_BAR(); }
        phase_g3(lds, l, wv);
        if (l == 0) phase_tail_transposes(lds, 2, wv);
        if (l != DEPTH - 1) GRID_BAR();
    }
#undef GRID_BAR
}

extern "C" void kernel_launch(void* const* d_in, const int* in_sizes, int n_in, void* d_out, int out_size, void* d_ws, size_t ws_size, hipStream_t stream) {
    static int grid = 0;
    if (grid == 0) {
        if (n_in != 20 || in_sizes[0] != NLAT * DM || out_size != NLAT * DM || ws_size < WS_END) {
            fprintf(stderr, "kernel_launch: shape mismatch: n_in %d in0 %d out %d ws %zu (need >= %zu)\n", n_in, n_in > 0 ? in_sizes[0] : -1, out_size, ws_size, (size_t)WS_END); grid = -1; return; }
        int dev = 0, cus = 0, per_cu = 0;
        if (hipGetDevice(&dev) != hipSuccess || hipDeviceGetAttribute(&cus, hipDeviceAttributeMultiprocessorCount, dev) != hipSuccess) { fprintf(stderr, "kernel_launch: device query failed\n"); grid = -1; return; }
        if (hipFuncSetAttribute((const void*)mega_fwd, hipFuncAttributeMaxDynamicSharedMemorySize, LDS_BYTES) != hipSuccess) { fprintf(stderr, "kernel_launch: hipFuncSetAttribute failed\n"); grid = -1; return; }
        if (hipOccupancyMaxActiveBlocksPerMultiprocessor(&per_cu, (const void*)mega_fwd, NWAVES * 64, LDS_BYTES) != hipSuccess || per_cu < 1)
            fprintf(stderr, "kernel_launch: note: occupancy query reports %d workgroups per CU\n", per_cu);
        (void)hipGetLastError();
        grid = cus;
    }
    if (grid < 0) return;
    if (hipMemsetAsync((char*)d_ws + WS_CTL, 0, CTL_ZERO_BYTES, stream) != hipSuccess) { fprintf(stderr, "kernel_launch: hipMemsetAsync failed\n"); return; }
    Args a{};
    for (int i = 0; i < 20; ++i) a.in[i] = (const float*)d_in[i];
    a.out = (float*)d_out; a.ws = (unsigned char*)d_ws;
    hipLaunchKernelGGL(mega_fwd, dim3(grid), dim3(NWAVES * 64), LDS_BYTES, stream, a);
    const hipError_t le = hipPeekAtLastError();
    if (le != hipSuccess) fprintf(stderr, "kernel_launch: launch failed: %s\n", hipGetErrorName(le));
}
```
